# Optimizing an MI355X kernel written in HIP

```python
import math, functools
import jax, jax.numpy as jnp
from jax import lax
import numpy as np

D_MODEL = 1024
BATCH = 8
SEQ = 2048
DEPTH = 2

GRID_W = 64
CTX_LEN = 256
D_MIX = D_MODEL
CONV_W = 4
CHUNK = 64
EPS = 1e-6
DA = D_MIX // 4
NH_A = 4
DH_A = DA // NH_A
DB = D_MIX // 2
HEAD_B = 64
NH_B = DB // HEAD_B
NG_B = 2
HPG_B = NH_B // NG_B
D_STATE = 64
DC = D_MIX - DA - DB
NB_C = 4
BW_C = DC // NB_C
RG_C = 8.0
D_FF = 4 * D_MODEL
SPLITS = (DA, DA, DA, DA, 2 * NH_A, 2 * NH_A, DB, DB, NG_B * D_STATE, NG_B * D_STATE, 2 * NH_B, DC, DC)
P_IN = sum(SPLITS)

kernel_name = "hybrid_mlstm_ssd_rglru_prefix_dit_block"


def rmsnorm(x, g):
    xf = x.astype(jnp.float32)
    y = xf * lax.rsqrt(jnp.mean(xf * xf, axis=-1, keepdims=True) + EPS)
    return (y * g.astype(jnp.float32)).astype(x.dtype)


def centred_conv(x, w, b):
    L = x.shape[1]
    left = CONV_W // 2
    xp = jnp.pad(x, ((0, 0), (left, CONV_W - 1 - left), (0, 0)))
    return b + sum(w[j] * xp[:, j:j + L] for j in range(CONV_W))


def split_proj(p):
    out, idx = [], 0
    for s in SPLITS:
        out.append(p[..., idx:idx + s])
        idx += s
    return out


def to_chunks(t):
    b, l = t.shape[:2]
    return jnp.moveaxis(t.reshape(b, l // CHUNK, CHUNK, *t.shape[2:]), 1, 0)


def from_chunks(t):
    t = jnp.moveaxis(t, 0, 1)
    return t.reshape(t.shape[0], -1, *t.shape[3:])


def to_column_major(t, rows):
    b, l, ch = t.shape
    return t.reshape(b, rows, GRID_W, ch).transpose(0, 2, 1, 3).reshape(b, l, ch)


def from_column_major(t, rows):
    b, l, ch = t.shape
    return t.reshape(b, GRID_W, rows, ch).transpose(0, 2, 1, 3).reshape(b, l, ch)


def bidirectional(scan_fns, ctx_in, lat_in, zero_state):
    y_ctx, y_lat = 0.0, 0.0
    for d in range(2):
        order = (lambda t: t) if d == 0 else (lambda t: jnp.flip(t, axis=1))
        yc, state = scan_fns[d](*[order(t) for t in ctx_in[d]], state=zero_state)
        yl, _ = scan_fns[d](*[order(t) for t in lat_in[d]], state=state)
        y_ctx = y_ctx + order(yc)
        y_lat = y_lat + order(yl)
    return y_ctx, y_lat


def mlstm_scan(q, k, v, ig, fg, state):
    tril = jnp.tril(jnp.ones((CHUNK, CHUNK), bool))[None, :, :, None]
    logf = jax.nn.log_sigmoid(fg)

    def step(carry, inp):
        C, n, m = carry
        qc, kc, vc, ic, lf = inp
        b = jnp.cumsum(lf, axis=1)
        dmat = jnp.where(tril, b[:, :, None] - b[:, None] + ic[:, None], -jnp.inf)
        inter = b + m[:, None]
        m_comb = jnp.maximum(inter, jnp.max(dmat, axis=2))
        s = jnp.einsum("bthd,bshd->btsh", qc, kc) * jnp.exp(dmat - m_comb[:, :, None])
        w_inter = jnp.exp(inter - m_comb)
        num = jnp.einsum("btsh,bshd->bthd", s, vc) + w_inter[..., None] * jnp.einsum("bhvk,bthk->bthv", C, qc)
        den = jnp.sum(s, axis=2) + w_inter * jnp.einsum("bhk,bthk->bth", n, qc)
        h = num / jnp.maximum(jnp.abs(den), jnp.exp(-m_comb))[..., None]
        b_end = b[:, -1]
        log_w = b_end[:, None] - b + ic
        m_new = jnp.maximum(b_end + m, jnp.max(log_w, axis=1))
        w = jnp.exp(log_w - m_new[:, None])
        decay = jnp.exp(b_end + m - m_new)
        C = decay[..., None, None] * C + jnp.einsum("bth,bthv,bthk->bhvk", w, vc, kc)
        n = decay[..., None] * n + jnp.einsum("bth,bthk->bhk", w, kc)
        return (C, n, m_new), h

    state, h = lax.scan(step, state, tuple(to_chunks(t) for t in (q, k, v, ig, logf)))
    return from_chunks(h), state


def ssd_scan(A, x, dt, Bm, Cm, state):
    tril = jnp.tril(jnp.ones((CHUNK, CHUNK), bool))[None, :, :, None, None]

    def step(h, inp):
        xc, dtc, bc, cc = inp
        cs = jnp.cumsum(dtc * A, axis=1)
        seg = jnp.exp(jnp.where(tril, cs[:, :, None] - cs[:, None], -jnp.inf))
        w = jnp.einsum("btgn,bsgn->btsg", cc, bc)[..., None] * seg * dtc[:, None]
        y = (jnp.einsum("btsge,bsgep->btgep", w, xc)
             + jnp.exp(cs)[..., None] * jnp.einsum("btgn,bgepn->btgep", cc, h))
        c_end = cs[:, -1]
        ws = jnp.exp(c_end[:, None] - cs) * dtc
        h = jnp.exp(c_end)[..., None, None] * h + jnp.einsum("bsge,bsgep,bsgn->bgepn", ws, xc, bc)
        return h, y

    state, y = lax.scan(step, state, tuple(to_chunks(t) for t in (x, dt, Bm, Cm)))
    return from_chunks(y), state


def rglru_scan(w_rg, b_rg, lam, x, state):
    bsz, L = x.shape[:2]
    gates = jnp.einsum("blnc,gncd->gblnd", x.reshape(bsz, L, NB_C, BW_C), w_rg).reshape(2, bsz, L, DC)
    gates = gates + b_rg[:, None, None]
    r, i = jax.nn.sigmoid(gates[0]), jax.nn.sigmoid(gates[1])
    log_a = -RG_C * r * jax.nn.softplus(-lam)
    a = jnp.exp(log_a)
    u = jnp.sqrt(-jnp.expm1(2.0 * log_a)) * (i * x)

    def combine(e1, e2):
        return e1[0] * e2[0], e2[0] * e1[1] + e2[1]

    a_cum, u_cum = lax.associative_scan(combine, (a, u), axis=1)
    h = a_cum * state[:, None] + u_cum
    return h, h[:, -1]


def mlstm_mixer(ctx_parts, lat_parts, conv_w, conv_b, b_ig, b_fg, g_head):
    def prep(q, k, v, o, ig, fg):
        bsz, L = q.shape[:2]
        qk = jax.nn.silu(centred_conv(jnp.concatenate([q, k], axis=-1), conv_w, conv_b))
        qh = qk[..., :DA].reshape(bsz, L, NH_A, DH_A) * (DH_A ** -0.5)
        kh = qk[..., DA:].reshape(bsz, L, NH_A, DH_A)
        vh = v.reshape(bsz, L, NH_A, DH_A)
        ig = ig.reshape(bsz, L, 2, NH_A) + b_ig
        fg = fg.reshape(bsz, L, 2, NH_A) + b_fg
        return [(qh, kh, vh, ig[:, :, d], fg[:, :, d]) for d in range(2)], o

    ctx_in, o_c = prep(*ctx_parts)
    lat_in, o_l = prep(*lat_parts)
    bsz = o_c.shape[0]
    zero = (jnp.zeros((bsz, NH_A, DH_A, DH_A), jnp.float32),
            jnp.zeros((bsz, NH_A, DH_A), jnp.float32),
            jnp.zeros((bsz, NH_A), jnp.float32))
    h_c, h_l = bidirectional([mlstm_scan, mlstm_scan], ctx_in, lat_in, zero)

    def out(h, o):
        return rmsnorm(h, g_head).reshape(o.shape) * jax.nn.sigmoid(o)

    return out(h_c, o_c), out(h_l, o_l)


def ssd_mixer(ctx_parts, lat_parts, conv_w, conv_b, dt_bias, a_log, d_skip, g_norm):
    A = -jnp.exp(a_log).reshape(2, NG_B, HPG_B)

    def prep(z, xs, bs, cs, dt):
        bsz, L = z.shape[:2]
        xbc = jax.nn.silu(centred_conv(jnp.concatenate([xs, bs, cs], axis=-1), conv_w, conv_b))
        xh = xbc[..., :DB].reshape(bsz, L, NG_B, HPG_B, HEAD_B)
        bm = xbc[..., DB:DB + NG_B * D_STATE].reshape(bsz, L, NG_B, D_STATE)
        cm = xbc[..., DB + NG_B * D_STATE:].reshape(bsz, L, NG_B, D_STATE)
        dt = jax.nn.softplus(dt.reshape(bsz, L, 2, NG_B, HPG_B) + dt_bias.reshape(2, NG_B, HPG_B))
        return [(xh, dt[:, :, d], bm, cm) for d in range(2)], (xh, z)

    ctx_in, e_c = prep(*ctx_parts)
    lat_in, e_l = prep(*lat_parts)
    bsz = e_c[1].shape[0]
    zero = jnp.zeros((bsz, NG_B, HPG_B, HEAD_B, D_STATE), jnp.float32)
    scans = [functools.partial(ssd_scan, A[d]) for d in range(2)]
    y_c, y_l = bidirectional(scans, ctx_in, lat_in, zero)

    def out(y, extra):
        xh, z = extra
        y = y + d_skip.reshape(NG_B, HPG_B, 1) * xh
        return rmsnorm(y.reshape(z.shape) * jax.nn.silu(z), g_norm)

    return out(y_c, e_c), out(y_l, e_l)


def rglru_mixer(ctx_parts, lat_parts, rows, conv_w, conv_b, w_rg, b_rg, lam):
    xr_c, gr_c = ctx_parts
    xr_l, gr_l = lat_parts
    xc = centred_conv(xr_c, conv_w, conv_b)
    xl = centred_conv(to_column_major(xr_l, rows), conv_w, conv_b)
    zero = jnp.zeros((xc.shape[0], DC), jnp.float32)
    scans = [functools.partial(rglru_scan, w_rg[d], b_rg[d], lam[d]) for d in range(2)]
    h_c, h_l = bidirectional(scans, [(xc,), (xc,)], [(xl,), (xl,)], zero)
    return h_c * jax.nn.gelu(gr_c), from_column_major(h_l, rows) * jax.nn.gelu(gr_l)


def token_mixers(p_ctx, p_lat, rows, conv_a_w, conv_a_b, b_ig, b_fg, g_head_a, conv_b_w, conv_b_b,
                 dt_bias, a_log, d_skip, g_norm_b, conv_c_w, conv_c_b, w_rg, b_rg, lam):
    pc = split_proj(p_ctx.astype(jnp.float32))
    pl = split_proj(p_lat.astype(jnp.float32))
    a_c, a_l = mlstm_mixer(pc[0:6], pl[0:6], conv_a_w, conv_a_b, b_ig, b_fg, g_head_a)
    b_c, b_l = ssd_mixer(pc[6:11], pl[6:11], conv_b_w, conv_b_b, dt_bias, a_log, d_skip, g_norm_b)
    c_c, c_l = rglru_mixer(pc[11:13], pl[11:13], rows, conv_c_w, conv_c_b, w_rg, b_rg, lam)
    return jnp.concatenate([a_c, b_c, c_c], axis=-1), jnp.concatenate([a_l, b_l, c_l], axis=-1)


def modulation(cvec, w_ada, b_ada):
    m = jax.nn.silu(cvec) @ w_ada + b_ada
    return jnp.split(m[:, None, :], 6, axis=-1)


def modulate(h, shift, scale):
    return h * (1.0 + scale) + shift


def sq_relu_mlp(h, w1, b1, w2, b2):
    return jnp.square(jax.nn.relu(h @ w1 + b1)) @ w2 + b2


def setup_inputs(seed: int = 0) -> dict:
    key = jax.random.key(seed)
    keys = iter(jax.random.split(key, 48))

    def nrm(shape, scale):
        return scale * jax.random.normal(next(keys), shape, jnp.float32)

    def unif(shape, lo, hi):
        return jax.random.uniform(next(keys), shape, jnp.float32, lo, hi)

    def gain(shape):
        return 1.0 + nrm(shape, 0.02)

    n_xbc = DB + 2 * NG_B * D_STATE
    dt0 = jnp.exp(unif((DEPTH, 2, NH_B), math.log(1e-3), math.log(1e-1)))
    log_a0 = jnp.log(unif((DEPTH, 2, DC), 0.9, 0.999)) / RG_C
    return {
        "x": nrm((BATCH, SEQ, D_MODEL), 1.0),
        "c": nrm((BATCH, D_MODEL), 1.0),
        "ctx": nrm((BATCH, CTX_LEN, D_MODEL), 1.0),
        "c_ctx": nrm((D_MODEL,), 1.0),
        "w_ada": nrm((DEPTH, D_MODEL, 6 * D_MODEL), 0.5 * D_MODEL ** -0.5),
        "b_ada": nrm((DEPTH, 6 * D_MODEL), 0.02),
        "g_mix": gain((DEPTH, D_MODEL)),
        "w_in": nrm((DEPTH, D_MODEL, P_IN), D_MODEL ** -0.5),
        "conv_a_w": nrm((DEPTH, CONV_W, 2 * DA), 0.5),
        "conv_a_b": nrm((DEPTH, 2 * DA), 0.02),
        "b_ig": nrm((DEPTH, 2, NH_A), 0.1),
        "b_fg": jnp.linspace(3.0, 6.0, NH_A) + nrm((DEPTH, 2, NH_A), 0.1),
        "g_head_a": gain((DEPTH, NH_A, DH_A)),
        "conv_b_w": nrm((DEPTH, CONV_W, n_xbc), 0.5),
        "conv_b_b": nrm((DEPTH, n_xbc), 0.02),
        "dt_bias": dt0 + jnp.log(-jnp.expm1(-dt0)),
        "a_log": jnp.log(unif((DEPTH, 2, NH_B), 1.0, 16.0)),
        "d_skip": 1.0 + nrm((DEPTH, NH_B), 0.1),
        "g_norm_b": gain((DEPTH, DB)),
        "conv_c_w": nrm((DEPTH, CONV_W, DC), 0.5),
        "conv_c_b": nrm((DEPTH, DC), 0.02),
        "w_rg": nrm((DEPTH, 2, 2, NB_C, BW_C, BW_C), BW_C ** -0.5),
        "b_rg": nrm((DEPTH, 2, 2, DC), 0.1),
        "lam": log_a0 - jnp.log(-jnp.expm1(log_a0)),
        "w_out": nrm((DEPTH, D_MIX, D_MODEL), D_MIX ** -0.5),
        "g_mlp": gain((DEPTH, D_MODEL)),
        "w_mlp1": nrm((DEPTH, D_MODEL, D_FF), D_MODEL ** -0.5),
        "b_mlp1": nrm((DEPTH, D_FF), 0.02),
        "w_mlp2": nrm((DEPTH, D_FF, D_MODEL), D_FF ** -0.5),
        "b_mlp2": nrm((DEPTH, D_MODEL), 0.02),
        "g_final": gain((D_MODEL,)),
    }


def reference(x, c, ctx, c_ctx, w_ada, b_ada, g_mix, w_in, conv_a_w, conv_a_b, b_ig, b_fg, g_head_a,
              conv_b_w, conv_b_b, dt_bias, a_log, d_skip, g_norm_b, conv_c_w, conv_c_b, w_rg, b_rg, lam,
              w_out, g_mlp, w_mlp1, b_mlp1, w_mlp2, b_mlp2, g_final):
    rows = x.shape[1] // GRID_W
    h_ctx = ctx
    for l in range(DEPTH):
        last = l == DEPTH - 1
        sh1, sc1, gt1, sh2, sc2, gt2 = modulation(c, w_ada[l], b_ada[l])
        csh1, csc1, cgt1, csh2, csc2, cgt2 = modulation(c_ctx[None], w_ada[l], b_ada[l])
        p_lat = modulate(rmsnorm(x, g_mix[l]), sh1, sc1) @ w_in[l]
        p_ctx = modulate(rmsnorm(h_ctx, g_mix[l]), csh1, csc1) @ w_in[l]
        y_ctx, y_lat = token_mixers(p_ctx, p_lat, rows, conv_a_w[l], conv_a_b[l], b_ig[l], b_fg[l],
                                    g_head_a[l], conv_b_w[l], conv_b_b[l], dt_bias[l], a_log[l],
                                    d_skip[l], g_norm_b[l], conv_c_w[l], conv_c_b[l], w_rg[l],
                                    b_rg[l], lam[l])
        x = x + gt1 * (y_lat.astype(x.dtype) @ w_out[l])
        x = x + gt2 * sq_relu_mlp(modulate(rmsnorm(x, g_mlp[l]), sh2, sc2),
                                  w_mlp1[l], b_mlp1[l], w_mlp2[l], b_mlp2[l])
        if not last:
            h_ctx = h_ctx + cgt1 * (y_ctx.astype(h_ctx.dtype) @ w_out[l])
            h_ctx = h_ctx + cgt2 * sq_relu_mlp(modulate(rmsnorm(h_ctx, g_mlp[l]), csh2, csc2),
                                              w_mlp1[l], b_mlp1[l], w_mlp2[l], b_mlp2[l])
    return rmsnorm(x, g_final)
```

```cpp
#include <hip/hip_runtime.h>
#include <hip/hip_cooperative_groups.h>
#include <cstdio>
#include <cstdint>
namespace cg = cooperative_groups;
__device__ __forceinline__ int tid_opaque() { int t = threadIdx.x; asm volatile("" : "+v"(t)); return t; }
namespace pg8 {
#define PG8_LAS __attribute__((address_space(3)))
typedef unsigned short bf16_t;
typedef short bf16x8 __attribute__((ext_vector_type(8)));
typedef float f32x4 __attribute__((ext_vector_type(4)));
typedef unsigned u32x4 __attribute__((ext_vector_type(4)));
constexpr int BM = 256, BK = 64, HALF = 128, HTB = HALF * BK * 2  , STAGE_BYTES = 8 * HTB, NXCD = 8, WGM = 8;

__host__ __device__ __forceinline__ int lds_byte(int r, int c) { const int st = (r >> 4) * 2 + (c >> 5), rr = r & 15, cc = c & 31, ob = rr * 64 + cc * 2; return st * 1024 + (ob ^ (((ob >> 9) & 1) << 5)); }
__host__ __device__ __forceinline__ void stage_rc(int b, int& R, int& C) { const int st = b / 1024, sb = b % 1024, swz = sb ^ (((sb >> 9) & 1) << 5); R = (st >> 1) * 16 + swz / 64; C = (st & 1) * 32 + (swz % 64) / 2; }
__host__ __device__ __forceinline__ int perm32(int rho) { const int n = rho >> 4, i = rho & 15; return 8 * (i >> 2) + 4 * n + (i & 3); }

struct Unit { int pm, pn, ks; };
struct Gemm { const bf16_t* A; const bf16_t* Bt; int M, N, K, ld; };

struct StaticOrder {
    int nM, nN, nwg, G, c;
    __host__ __device__ void init(int M, int N, int G_, int c_) { nM = M / BM; nN = N / BM; nwg = nM * nN; G = G_; c = c_; }
    __host__ __device__ bool next(int i, Unit& u) const {
        const long L = (long)i * G + c; if (L >= nwg) return false;
        int wgid = (int)L; { const int q = nwg / NXCD, r = nwg % NXCD, xcd = wgid % NXCD, off = wgid / NXCD; wgid = (xcd < r ? xcd * (q + 1) : r * (q + 1) + (xcd - r) * q) + off; }
        const int nig = WGM * nN, gid = wgid / nig, fm = gid * WGM, gsz = (nM - fm) < WGM ? (nM - fm) : WGM;
        u.pm = fm + ((wgid % nig) % gsz); u.pn = (wgid % nig) / gsz; u.ks = 0; return true;
    }
    __device__ __forceinline__ void a_ready(const Unit&) const {}
    __device__ __forceinline__ void done(const Unit&) const {}
};

__device__ __forceinline__ unsigned cvt_pk_bf16(float lo, float hi) { unsigned r; asm volatile("v_cvt_pk_bf16_f32 %0, %1, %2" : "=v"(r) : "v"(lo), "v"(hi)); return r; }
typedef float f32x2 __attribute__((ext_vector_type(2)));
template <class Epi, class Sched, bool ALIGN_EPI = false, bool SP2 = false>
__device__ __forceinline__ void gemm_phase(PG8_LAS unsigned char* lds, const Gemm g, const Sched& S, const Epi& E) {
    const int tid = tid_opaque(), wid = __builtin_amdgcn_readfirstlane(tid >> 6), lane = tid & 63, wr = wid >> 2, wc = wid & 3, fr = lane & 15, fq = lane >> 4;
    const int K = g.K, nt = K / BK, ld = g.ld;
    unsigned voffA[2], voffB[2];
#pragma unroll
    for (int i = 0; i < 2; ++i) { int R, C; stage_rc(tid * 16 + i * 8192, R, C); const int Rb = Epi::PERM ? ((R & ~31) + perm32(R & 31)) : R;
        voffA[i] = (unsigned)(R * ld + C) * 2u; voffB[i] = (unsigned)(Rb * ld + C) * 2u; }
    const size_t kstep = (size_t)(BK * 2);
    const size_t hstep = (size_t)HALF * ld * 2;
    const size_t tstep = 2 * hstep;
    const unsigned ldsw = (unsigned)wid * 1024u;
    const int aoff = lds_byte(wr * 64 + fr, fq * 8), boff = lds_byte(wc * 32 + fr, fq * 8);
#define PG8_SA(b, h) (((b) * 2 + (h)) * HTB)
#define PG8_SB(b, h) ((4 + (b) * 2 + (h)) * HTB)
#define PG8_STAGE(bufoff, gbase, voff) do { _Pragma("unroll") for (int _i = 0; _i < 2; ++_i) \
        __builtin_amdgcn_global_load_lds((const unsigned*)((const char*)(gbase) + (voff)[_i]), (PG8_LAS unsigned*)(lds + (bufoff) + ldsw + _i * 8192), 16, 0, 0); } while (0)
#define PG8_LDA(dst, b, h) do { _Pragma("unroll") for (int m = 0; m < 4; ++m) _Pragma("unroll") for (int k = 0; k < 2; ++k) dst[m][k] = *(const PG8_LAS bf16x8*)(lds + PG8_SA(b, h) + aoff + m * 2048 + k * 1024); } while (0)
#define PG8_LDB(dst, b, h) do { _Pragma("unroll") for (int n = 0; n < 2; ++n) _Pragma("unroll") for (int k = 0; k < 2; ++k) dst[n][k] = *(const PG8_LAS bf16x8*)(lds + PG8_SB(b, h) + boff + n * 2048 + k * 1024); } while (0)
#define PG8_MMA(ai, bj, At, Bt) do { __builtin_amdgcn_s_setprio(1); _Pragma("unroll") for (int m = 0; m < 4; ++m) _Pragma("unroll") for (int n = 0; n < 2; ++n) _Pragma("unroll") for (int k = 0; k < 2; ++k) \
        acc[ai][bj][m][n] = __builtin_amdgcn_mfma_f32_16x16x32_bf16(Bt[n][k], At[m][k], acc[ai][bj][m][n], 0, 0, 0); __builtin_amdgcn_s_setprio(0); } while (0)
#define PG8_WAIT_V(n) asm volatile("s_waitcnt vmcnt(" #n ")" ::: "memory")
#define PG8_WAIT_L(n) asm volatile("s_waitcnt lgkmcnt(" #n ")" ::: "memory")
#define PG8_BAR __builtin_amdgcn_s_barrier()
#define PG8_SCHED __builtin_amdgcn_sched_barrier(0)
    Unit cur, nxt; int ui = 0;
    if (!S.next(0, cur)) return;
    f32x4 acc[2][2][4][2];
#pragma unroll
    for (int a = 0; a < 2; ++a)
#pragma unroll
        for (int b = 0; b < 2; ++b)
#pragma unroll
            for (int m = 0; m < 4; ++m)
#pragma unroll
                for (int n = 0; n < 2; ++n) acc[a][b][m][n] = (f32x4){0.f, 0.f, 0.f, 0.f};
    bf16x8 At[4][2], B0[2][2], B1[2][2];
    const size_t sstep = (size_t)K * 2;
    const char* cA = (const char*)g.A + (size_t)cur.pm * tstep + (size_t)cur.ks * sstep; const char* cB = (const char*)g.Bt + (size_t)cur.pn * tstep + (size_t)cur.ks * sstep;
    S.a_ready(cur);
    if constexpr (SP2) {
        PG8_STAGE(PG8_SB(0, 0), cB, voffB); PG8_STAGE(PG8_SB(0, 1), cB + hstep, voffB); PG8_STAGE(PG8_SA(0, 0), cA, voffA); PG8_STAGE(PG8_SA(0, 1), cA + hstep, voffA);
        if (wr == 1) PG8_BAR;
        PG8_WAIT_V(2); PG8_BAR;
        PG8_STAGE(PG8_SB(1, 0), cB + kstep, voffB); PG8_STAGE(PG8_SA(1, 0), cA + kstep, voffA); PG8_STAGE(PG8_SB(1, 1), cB + hstep + kstep, voffB);
        PG8_WAIT_V(6); PG8_BAR;
    } else {
        PG8_STAGE(PG8_SB(0, 0), cB, voffB); PG8_STAGE(PG8_SA(0, 0), cA, voffA); PG8_STAGE(PG8_SB(0, 1), cB + hstep, voffB); PG8_STAGE(PG8_SA(0, 1), cA + hstep, voffA);
        if (wr == 1) PG8_BAR;
        PG8_WAIT_V(4); PG8_BAR;
        PG8_STAGE(PG8_SB(1, 0), cB + kstep, voffB); PG8_STAGE(PG8_SA(1, 0), cA + kstep, voffA); PG8_STAGE(PG8_SB(1, 1), cB + hstep + kstep, voffB);
        PG8_WAIT_V(6); PG8_BAR;
    }
    for (;;) {
        const bool has_next = S.next(ui + 1, nxt);
        const char* nA = has_next ? (const char*)g.A + (size_t)nxt.pm * tstep + (size_t)nxt.ks * sstep : cA; const char* nB = has_next ? (const char*)g.Bt + (size_t)nxt.pn * tstep + (size_t)nxt.ks * sstep : cB;
        for (int t = 0; t < nt; t += 2) {
            const bool last = (t == nt - 2);
            const char* a1 = cA + (size_t)(t + 1) * kstep;
            const char* a2 = last ? nA : cA + (size_t)(t + 2) * kstep; const char* b2 = last ? nB : cB + (size_t)(t + 2) * kstep;
            const char* a3 = a2 + kstep; const char* b3 = b2 + kstep;
            if (last && has_next) S.a_ready(nxt);
            if constexpr (SP2) {
            PG8_LDB(B0, 0, 0); PG8_LDB(B1, 0, 1); PG8_SCHED; PG8_LDA(At, 0, 0); PG8_STAGE(PG8_SA(1, 1), a1 + hstep, voffA);
            PG8_WAIT_V(8); PG8_WAIT_L(0); PG8_BAR; PG8_MMA(0, 0, At, B0); PG8_MMA(0, 1, At, B1); PG8_BAR; PG8_SCHED;
            PG8_LDA(At, 0, 1); PG8_STAGE(PG8_SB(0, 0), b2, voffB); PG8_STAGE(PG8_SB(0, 1), b2 + hstep, voffB); PG8_STAGE(PG8_SA(0, 0), a2, voffA);
            PG8_WAIT_V(8); PG8_WAIT_L(0); PG8_BAR; PG8_MMA(1, 0, At, B0); PG8_MMA(1, 1, At, B1); PG8_BAR; PG8_SCHED;
            PG8_LDB(B0, 1, 0); PG8_LDB(B1, 1, 1); PG8_SCHED; PG8_LDA(At, 1, 0); PG8_STAGE(PG8_SA(0, 1), a2 + hstep, voffA);
            PG8_WAIT_V(8); PG8_WAIT_L(0); PG8_BAR; PG8_MMA(0, 0, At, B0); PG8_MMA(0, 1, At, B1); PG8_BAR; PG8_SCHED;
            PG8_LDA(At, 1, 1); PG8_STAGE(PG8_SB(1, 0), b3, voffB); PG8_STAGE(PG8_SB(1, 1), b3 + hstep, voffB); PG8_STAGE(PG8_SA(1, 0), a3, voffA);
            PG8_WAIT_V(8); PG8_WAIT_L(0); PG8_BAR; PG8_MMA(1, 0, At, B0); PG8_MMA(1, 1, At, B1); PG8_BAR; PG8_SCHED;
            } else {
            PG8_LDB(B0, 0, 0); PG8_SCHED; PG8_LDA(At, 0, 0); PG8_STAGE(PG8_SA(1, 1), a1 + hstep, voffA);
            PG8_WAIT_L(8); PG8_BAR; PG8_WAIT_L(0); PG8_MMA(0, 0, At, B0); PG8_BAR; PG8_SCHED;
            PG8_LDB(B1, 0, 1); PG8_STAGE(PG8_SB(0, 0), b2, voffB);
            PG8_BAR; PG8_WAIT_L(0); PG8_MMA(0, 1, At, B1); PG8_BAR;
            PG8_LDA(At, 0, 1); PG8_STAGE(PG8_SA(0, 0), a2, voffA);
            PG8_BAR; PG8_WAIT_L(0); PG8_MMA(1, 0, At, B0); PG8_BAR; PG8_SCHED;
            PG8_STAGE(PG8_SB(0, 1), b2 + hstep, voffB);
            PG8_WAIT_V(6); PG8_BAR; PG8_MMA(1, 1, At, B1); PG8_BAR;
            PG8_LDB(B0, 1, 0); PG8_SCHED; PG8_LDA(At, 1, 0); PG8_STAGE(PG8_SA(0, 1), a2 + hstep, voffA);
            PG8_WAIT_L(8); PG8_BAR; PG8_WAIT_L(0); PG8_MMA(0, 0, At, B0); PG8_BAR; PG8_SCHED;
            PG8_LDB(B1, 1, 1); PG8_STAGE(PG8_SB(1, 0), b3, voffB);
            PG8_BAR; PG8_WAIT_L(0); PG8_MMA(0, 1, At, B1); PG8_BAR;
            PG8_LDA(At, 1, 1); PG8_STAGE(PG8_SA(1, 0), a3, voffA);
            PG8_BAR; PG8_WAIT_L(0); PG8_MMA(1, 0, At, B0); PG8_BAR; PG8_SCHED;
            PG8_STAGE(PG8_SB(1, 1), b3 + hstep, voffB);
            PG8_WAIT_V(6); PG8_BAR; PG8_MMA(1, 1, At, B1); PG8_BAR;
            }
        }
        if constexpr (ALIGN_EPI) { if (wr == 0) PG8_BAR; }
        if constexpr (!Epi::AFTER_DRAIN) { E(acc, cur, wr, wc, fr, fq); S.done(cur); }
        if (!has_next) break;
#pragma unroll
        for (int a = 0; a < 2; ++a)
#pragma unroll
            for (int b = 0; b < 2; ++b)
#pragma unroll
                for (int m = 0; m < 4; ++m)
#pragma unroll
                    for (int n = 0; n < 2; ++n) acc[a][b][m][n] = (f32x4){0.f, 0.f, 0.f, 0.f};
        cur = nxt; cA = nA; cB = nB; ++ui;
        if constexpr (ALIGN_EPI) { if (wr == 1) PG8_BAR; }
    }
    PG8_WAIT_V(0);
    if constexpr (!ALIGN_EPI) { if (wr == 0) PG8_BAR; }
    PG8_BAR;
    if constexpr (Epi::AFTER_DRAIN) { E.fused(acc, cur, wr, wc, fr, fq, lds, wid, lane); S.done(cur); }
#undef PG8_SA
#undef PG8_SB
#undef PG8_STAGE
#undef PG8_LDA
#undef PG8_LDB
#undef PG8_MMA
#undef PG8_WAIT_V
#undef PG8_WAIT_L
#undef PG8_BAR
#undef PG8_SCHED
}
}

#ifndef MK_N_LAUNCHES
#define MK_N_LAUNCHES 1
#endif

#define LAS __attribute__((address_space(3)))
typedef unsigned short bf16_t;
typedef unsigned u32x4 __attribute__((ext_vector_type(4)));
typedef unsigned u32x2 __attribute__((ext_vector_type(2)));
typedef float f32x4 __attribute__((ext_vector_type(4)));
typedef float f32x2 __attribute__((ext_vector_type(2)));
typedef short bf16x8 __attribute__((ext_vector_type(8)));

constexpr int D = 1024, NBATCH = 8, SEQL = 2048, CTXL = 256;
constexpr int RL = NBATCH * SEQL;
constexpr int RC = NBATCH * CTXL;
constexpr int RT = RL + RC;
constexpr int PIN = 2848, PINP = 3072, PALD = 1536, PRLD = 1280, FF = 4096;
constexpr float EPS = 1e-6f;
constexpr int NTHREADS = 512, NWAVES = 8;
constexpr int LDS_BYTES = 163840;
constexpr int LDS_BARST = LDS_BYTES - 16;
constexpr int NPHASES = 22;

constexpr size_t MiB = 1u << 20;
constexpr size_t WS_WT = 0;
constexpr size_t WT_LAYER = 24 * MiB, WT_OUT = 6 * MiB, WT_W1 = 8 * MiB, WT_W2 = 16 * MiB;
constexpr size_t WS_XN = 48 * MiB;
constexpr size_t WS_PA = 84 * MiB;
constexpr size_t WS_PR = 138 * MiB;
constexpr size_t WS_CV = 183 * MiB;
constexpr size_t WS_RAWB = 84 * MiB;
constexpr size_t WS_H = 84 * MiB;
constexpr size_t WS_CTXRES = 237 * MiB;
constexpr size_t WS_GATES = 245 * MiB;
constexpr size_t WS_MOD = 248 * MiB;
constexpr size_t WS_CTL = 249 * MiB;
constexpr size_t CTL_BYTES = 16384;
constexpr size_t WS_PART = WS_H;
constexpr size_t WS_END = 250 * MiB;

struct Params { const float* in[31]; float* out; unsigned char* ws; int lo, hi; };

enum { I_X = 0, I_C, I_CTX, I_CCTX, I_WADA, I_BADA, I_GMIX, I_WIN, I_CAW, I_CAB, I_BIG, I_BFG, I_GHA, I_CBW, I_CBB, I_DTB, I_ALOG, I_DSKIP, I_GNB,
       I_CCW, I_CCB, I_WRG, I_BRG, I_LAM, I_WOUT, I_GMLP, I_W1, I_B1, I_W2, I_B2, I_GFIN };

__device__ __forceinline__ unsigned f2bf(float f) { unsigned u = __builtin_bit_cast(unsigned, f); return (u + 0x7fffu + ((u >> 16) & 1u)) >> 16; }
typedef __bf16 bf16x2_t __attribute__((ext_vector_type(2)));
__device__ __forceinline__ unsigned pk2(float lo, float hi) { const f32x2 v = {lo, hi}; const bf16x2_t b = __builtin_convertvector(v, bf16x2_t); return __builtin_bit_cast(unsigned, b); }
__device__ __forceinline__ float bf_lo(unsigned u) { return __builtin_bit_cast(float, u << 16); }
__device__ __forceinline__ float bf_hi(unsigned u) { return __builtin_bit_cast(float, u & 0xffff0000u); }
__device__ __forceinline__ float bf1(unsigned short h) { return __builtin_bit_cast(float, ((unsigned)h) << 16); }
__device__ __forceinline__ float wave_sum(float v) {
#pragma unroll
    for (int o = 1; o < 64; o <<= 1) v += __shfl_xor(v, o);
    return v;
}
__device__ __forceinline__ float sigmoidf_(float x) { return __builtin_amdgcn_rcpf(1.f + __expf(-x)); }
__device__ __forceinline__ float siluf_(float x) { return x * __builtin_amdgcn_rcpf(1.f + __expf(-x)); }
__device__ __forceinline__ float softplusf_(float x) { return fmaxf(x, 0.f) + log1pf(__expf(-fabsf(x))); }
__device__ __forceinline__ float gelu_tanh(float x) { const float u = 0.7978845608028654f * (x + 0.044715f * x * x * x); const float e = __expf(2.f * u); const float th = 1.f - 2.f / (e + 1.f); return 0.5f * x * (1.f + th); }

__device__ __forceinline__ void st16_wt(void* ptr, u32x4 v) { asm volatile("global_store_dwordx4 %0, %1, off sc1\n\ts_nop 1" :: "v"(ptr), "v"(v) : "memory"); }
__device__ __forceinline__ void st16_wt(void* ptr, f32x4 v) { asm volatile("global_store_dwordx4 %0, %1, off sc1\n\ts_nop 1" :: "v"(ptr), "v"(v) : "memory"); }
__device__ __forceinline__ void st8_wt(void* ptr, u32x2 v) { __hip_atomic_store((unsigned long long*)ptr, __builtin_bit_cast(unsigned long long, v), __ATOMIC_RELAXED, __HIP_MEMORY_SCOPE_AGENT); }
__device__ __forceinline__ void st4_wt(float* ptr, float v) { __hip_atomic_store(ptr, v, __ATOMIC_RELAXED, __HIP_MEMORY_SCOPE_AGENT); }
#define LDS_BARRIER() asm volatile("s_waitcnt lgkmcnt(0)\n\ts_barrier" ::: "memory")
constexpr int LS = 72;
__device__ __forceinline__ f32x4 mma64(const LAS bf16_t* A, const LAS bf16_t* Bt, int lane, f32x4 acc) {
    const int r = lane & 15, q = lane >> 4;
#pragma unroll
    for (int kk = 0; kk < 2; ++kk) {
        const bf16x8 a = *(const LAS bf16x8*)(A + r * LS + kk * 32 + q * 8);
        const bf16x8 b = *(const LAS bf16x8*)(Bt + r * LS + kk * 32 + q * 8);
        acc = __builtin_amdgcn_mfma_f32_16x16x32_bf16(a, b, acc, 0, 0, 0);
    }
    return acc;
}

typedef short v4i16_t __attribute__((ext_vector_type(4)));
__device__ __forceinline__ bf16x8 tr_frag(const LAS bf16_t* T, int ld, int ctile, int kk, int lane) {
    const int g = lane >> 4, q = (lane & 15) >> 2, pp = lane & 3;
    const LAS bf16_t* a0 = T + (32 * kk + 8 * g + q) * ld + 16 * ctile + 4 * pp;
    const v4i16_t lo = __builtin_amdgcn_ds_read_tr16_b64_v4i16((LAS v4i16_t*)a0), hi = __builtin_amdgcn_ds_read_tr16_b64_v4i16((LAS v4i16_t*)(a0 + 4 * ld));
    return (bf16x8){lo.x, lo.y, lo.z, lo.w, hi.x, hi.y, hi.z, hi.w};
}
#define XB_TMO      128
#define XB_XCNT(j)  (256  + 64 * (j))
#define XB_XSUB(j)  (1280 + 64 * (j))
#define XB_XGEN(j)  (2304 + 64 * (j))
#define XB_TOP      3328
#define XB_TOPGEN   3392
#define XCD_BAR_WORDS 3456
#define XB_SPIN_CAP (1u << 18)

__device__ __forceinline__ unsigned xb_ld(unsigned* p)              { return __hip_atomic_load(p, __ATOMIC_RELAXED, __HIP_MEMORY_SCOPE_AGENT); }
__device__ __forceinline__ unsigned xb_add(unsigned* p, unsigned v) { return __hip_atomic_fetch_add(p, v, __ATOMIC_RELAXED, __HIP_MEMORY_SCOPE_AGENT); }
__device__ __forceinline__ unsigned xb_xcc_id() { return (unsigned)__builtin_amdgcn_s_getreg((3 << 11) | 20) & 0xFu; }
#define XB_SPIN(cond, bar) do { unsigned _sp = 0; while (cond) { __builtin_amdgcn_s_sleep(1); \
    if ((++_sp & 255u) == 0u) { if (xb_ld(&(bar)[XB_TMO])) break; if (_sp > XB_SPIN_CAP) { atomicAdd(&(bar)[XB_TMO], 1u); break; } } } } while (0)

struct XcdBarrier {
    unsigned* bar; unsigned x;
    volatile LAS unsigned* st;
};

__device__ __forceinline__ XcdBarrier xcd_barrier_post(unsigned* bar, volatile LAS unsigned* st) {
    XcdBarrier b; b.bar = bar; b.x = xb_xcc_id(); b.st = st;
    if (threadIdx.x == 0) (void)xb_add(&bar[XB_XCNT(b.x)], 1u);
    return b;
}
__device__ __forceinline__ void xcd_barrier_complete(unsigned* bar, unsigned x, unsigned& nloc, unsigned& nx) {
    const unsigned G = gridDim.x * gridDim.y * gridDim.z;
    unsigned sum, cnt, mine, sp = 0u;
    for (;;) {
        sum = 0u; cnt = 0u; mine = 0u;
#pragma unroll
        for (unsigned j = 0; j < 16; ++j) { const unsigned c = xb_ld(&bar[XB_XCNT(j)]); sum += c; cnt += (c > 0u) ? 1u : 0u; mine = (j == x) ? c : mine; }
        if (sum == G) break;
        __builtin_amdgcn_s_sleep(1);
        if ((++sp & 255u) == 0u) { if (xb_ld(&bar[XB_TMO])) break; if (sp > XB_SPIN_CAP) { atomicAdd(&bar[XB_TMO], 1u); break; } }
    }
    nloc = mine > 0u ? mine : 1u; nx = cnt > 0u ? cnt : 1u;
}

__device__ __forceinline__ void xcd_barrier(const XcdBarrier& b) {
    asm volatile("s_waitcnt vmcnt(0)" ::: "memory");
    __syncthreads();
    if (threadIdx.x == 0) {
        unsigned* bar = b.bar;
        __builtin_amdgcn_s_waitcnt(0);
        unsigned nloc = b.st[0], nx = b.st[1];
        if (nloc == 0u) { xcd_barrier_complete(bar, b.x, nloc, nx); b.st[0] = nloc; b.st[1] = nx; }
        const unsigned old = xb_add(&bar[XB_XSUB(b.x)], 1u);
        const unsigned gen = old / nloc;
        if (old + 1u == (gen + 1u) * nloc) {
            __builtin_amdgcn_fence(__ATOMIC_RELEASE, "agent");
            asm volatile("s_waitcnt vmcnt(0)" ::: "memory");
            const unsigned og = xb_add(&bar[XB_TOP], 1u);
            const unsigned tg = og / nx;
            if (og + 1u == (tg + 1u) * nx) xb_add(&bar[XB_TOPGEN], 1u);
            else XB_SPIN(xb_ld(&bar[XB_TOPGEN]) == tg, bar);
            __builtin_amdgcn_fence(__ATOMIC_ACQUIRE, "agent");
            xb_add(&bar[XB_XGEN(b.x)], 1u);
            asm volatile("s_waitcnt vmcnt(0)" ::: "memory");
        } else {
            XB_SPIN(xb_ld(&bar[XB_XGEN(b.x)]) == gen, bar);
            __builtin_amdgcn_fence(__ATOMIC_ACQUIRE, "agent");
            asm volatile("s_waitcnt vmcnt(0)" ::: "memory");
        }
    }
    __syncthreads();
}

struct EpiAll {
    static constexpr bool PERM = true, AFTER_DRAIN = false;
    const Params* pp; int kind, l;
    __device__ __forceinline__ void operator()(const pg8::f32x4 (&acc)[2][2][4][2], const pg8::Unit& u, int wr, int wc, int fr, int fq) const {
        const Params& p = *pp;
        if (kind == 0) {
            const int row0 = u.pm * 256 + wr * 64 + fr;
            if (u.pn < 11) {
                const bool pa = u.pn < 6; const int ld = pa ? PALD : PRLD;
                bf16_t* P = (bf16_t*)(p.ws + (pa ? WS_PA : WS_PR));
                const int col0 = (pa ? u.pn : u.pn - 6) * 256 + wc * 32 + 8 * fq;
#pragma unroll
                for (int ai = 0; ai < 2; ++ai)
#pragma unroll
                    for (int m = 0; m < 4; ++m) { bf16_t* rowp = P + (size_t)(row0 + ai * 128 + m * 16) * ld + col0;
#pragma unroll
                        for (int bj = 0; bj < 2; ++bj) { const pg8::f32x4 v0 = acc[ai][bj][m][0], v1 = acc[ai][bj][m][1];
                            u32x4 w; w.x = pg8::cvt_pk_bf16(v0[0], v0[1]); w.y = pg8::cvt_pk_bf16(v0[2], v0[3]); w.z = pg8::cvt_pk_bf16(v1[0], v1[1]); w.w = pg8::cvt_pk_bf16(v1[2], v1[3]);
                            st16_wt(rowp + bj * 128, w); } }
            } else if (wc == 0) {
                float* gates = (float*)(p.ws + WS_GATES);
#pragma unroll
                for (int ai = 0; ai < 2; ++ai)
#pragma unroll
                    for (int m = 0; m < 4; ++m) { float* gp = gates + (size_t)(row0 + ai * 128 + m * 16) * 32 + 8 * fq;
                        st16_wt(gp, acc[ai][0][m][0]); st16_wt(gp + 4, acc[ai][0][m][1]); }
            }
        } else if (kind == 4) {
            bf16_t* part = (bf16_t*)(p.ws + WS_PART) + (size_t)u.ks * RC * D;
            const int row0 = u.pm * 256 + wr * 64 + fr; const int col0 = u.pn * 256 + wc * 32 + 8 * fq;
#pragma unroll
            for (int bj = 0; bj < 2; ++bj)
#pragma unroll
                for (int ai = 0; ai < 2; ++ai)
#pragma unroll
                    for (int m = 0; m < 4; ++m) { const pg8::f32x4 v0 = acc[ai][bj][m][0], v1 = acc[ai][bj][m][1];
                        u32x4 w; w.x = pk2(v0[0], v0[1]); w.y = pk2(v0[2], v0[3]); w.z = pk2(v1[0], v1[1]); w.w = pk2(v1[2], v1[3]);
                        st16_wt(part + (size_t)(row0 + ai * 128 + m * 16) * D + col0 + bj * 128, w); }
        } else if (kind == 2) {
            bf16_t* H = (bf16_t*)(p.ws + WS_H); const float* b1 = p.in[I_B1] + l * FF;
            const int row0 = u.pm * 256 + wr * 64 + fr; const int col0 = u.pn * 256 + wc * 32 + 8 * fq;
#pragma unroll
            for (int bj = 0; bj < 2; ++bj) { const int c = col0 + bj * 128;
                const f32x4 b0 = *(const f32x4*)(b1 + c), bb1 = *(const f32x4*)(b1 + c + 4);
#pragma unroll
                for (int ai = 0; ai < 2; ++ai)
#pragma unroll
                    for (int m = 0; m < 4; ++m) { f32x4 v0 = acc[ai][bj][m][0] + b0, v1 = acc[ai][bj][m][1] + bb1;
#pragma unroll
                        for (int i = 0; i < 4; ++i) { const float a = fmaxf(v0[i], 0.f), b = fmaxf(v1[i], 0.f); v0[i] = a * a; v1[i] = b * b; }
                        u32x4 w; w.x = pg8::cvt_pk_bf16(v0[0], v0[1]); w.y = pg8::cvt_pk_bf16(v0[2], v0[3]); w.z = pg8::cvt_pk_bf16(v1[0], v1[1]); w.w = pg8::cvt_pk_bf16(v1[2], v1[3]);
                        st16_wt(H + (size_t)(row0 + ai * 128 + m * 16) * FF + c, w); } }
        } else {
            const bool lat = u.pm < 64; const int bsel = lat ? (u.pm >> 3) : 8;
            const float* gate = (const float*)(p.ws + WS_MOD) + (size_t)(l * 9 + bsel) * 6144 + (kind == 1 ? 2 : 5) * 1024;
            const float* bias = p.in[I_B2] + l * D;
            const float bsc = kind == 3 ? 1.f : 0.f;
            const int rloc = (lat ? u.pm : u.pm - 64) * 256 + wr * 64 + fr;
            bf16_t* rs = lat ? (bf16_t*)p.out : (bf16_t*)(p.ws + WS_CTXRES);
            const bool f32src = (kind == 1 && l == 0);
            const float* ipf = (lat ? p.in[I_X] : p.in[I_CTX]) + (size_t)rloc * D;
            const bf16_t* ipb = rs + (size_t)rloc * D;
            bf16_t* op = ((kind == 3 && l == 1) ? (bf16_t*)(p.ws + WS_XN) : rs) + (size_t)rloc * D;
            const int col0 = u.pn * 256 + wc * 32 + 8 * fq;
#pragma unroll
            for (int bj = 0; bj < 2; ++bj) { const int c = col0 + bj * 128;
                const f32x4 g0 = *(const f32x4*)(gate + c), g1 = *(const f32x4*)(gate + c + 4);
                const f32x4 b0 = *(const f32x4*)(bias + c) * bsc, b1 = *(const f32x4*)(bias + c + 4) * bsc;
#pragma unroll
                for (int ai = 0; ai < 2; ++ai)
#pragma unroll
                    for (int m = 0; m < 4; ++m) { const size_t ro = (size_t)(ai * 128 + m * 16) * D + c;
                        f32x4 x0, x1;
                        if (f32src) { x0 = *(const f32x4*)(ipf + ro); x1 = *(const f32x4*)(ipf + ro + 4); }
                        else { const u32x4 xb = *(const u32x4*)(ipb + ro); x0 = (f32x4){bf_lo(xb.x), bf_hi(xb.x), bf_lo(xb.y), bf_hi(xb.y)}; x1 = (f32x4){bf_lo(xb.z), bf_hi(xb.z), bf_lo(xb.w), bf_hi(xb.w)}; }
                        const f32x4 y0 = x0 + g0 * (acc[ai][bj][m][0] + b0), y1 = x1 + g1 * (acc[ai][bj][m][1] + b1);
                        u32x4 w; w.x = pk2(y0[0], y0[1]); w.y = pk2(y0[2], y0[3]); w.z = pk2(y1[0], y1[1]); w.w = pk2(y1[2], y1[3]);
                        st16_wt(op + ro, w); } }
        }
    }
};

struct Order {
    pg8::StaticOrder so; int nslice;
    __device__ __forceinline__ bool next(int i, pg8::Unit& u) const {
        if (nslice == 0) return so.next(i, u);
        const int Lx = i * so.G + so.c; if (Lx >= nslice * 32) return false;
        u.ks = Lx >> 5; const int t = Lx & 31; u.pm = t >> 2; u.pn = t & 3; return true;
    }
    __device__ __forceinline__ void a_ready(const pg8::Unit&) const {}
    __device__ __forceinline__ void done(const pg8::Unit&) const {}
};
__device__ __forceinline__ int inproj_dest(int n) {
    if (n < 512) return n;
    if (n < 1024) return 1536 + (n - 512);
    if (n < 1040) return 2816 + (n - 1024);
    if (n < 1552) return 2048 + (n - 1040);
    if (n < 2064) return 512 + (n - 1552);
    if (n < 2320) return 1024 + (n - 2064);
    if (n < 2336) return 2832 + (n - 2320);
    if (n < 2592) return 1280 + (n - 2336);
    return 2560 + (n - 2592);
}
template <bool INMAP>
__device__ __forceinline__ void transpose_item(const float* W, int K, int N, bf16_t* WT, LAS float* scr, int item, int lane) {
    const int nblk = N / 32, kb = item / nblk, nb = item % nblk, k0 = 64 * kb, n0 = 32 * nb;
#pragma unroll 8
    for (int i = 0; i < 32; ++i) { const int kk = 2 * i + (lane >> 5); scr[kk * 33 + (lane & 31)] = W[(size_t)(k0 + kk) * N + n0 + (lane & 31)]; }
    asm volatile("s_waitcnt lgkmcnt(0)" ::: "memory");
    const int c = lane & 7;
#pragma unroll
    for (int j = 0; j < 4; ++j) { const int n = (lane >> 3) + 8 * j; const LAS float* s = scr + (8 * c) * 33 + n;
        u32x4 o; o.x = pk2(s[0 * 33], s[1 * 33]); o.y = pk2(s[2 * 33], s[3 * 33]); o.z = pk2(s[4 * 33], s[5 * 33]); o.w = pk2(s[6 * 33], s[7 * 33]);
        const int row = INMAP ? inproj_dest(n0 + n) : (n0 + n);
        st16_wt(WT + (size_t)row * K + k0 + 8 * c, o); }
    asm volatile("s_waitcnt lgkmcnt(0)" ::: "memory");
}
__device__ __forceinline__ void phase0(const Params& p, LAS unsigned char* L) {
    const int tid = tid_opaque(), lane = tid & 63, wave = tid >> 6;
    LAS float* sS = (LAS float*)L;
    LAS float* red = (LAS float*)(L + 36864);
    for (int i = tid; i < 9 * 1024; i += NTHREADS) { const int v = i >> 10, k = i & 1023; const float x = v < 8 ? p.in[I_C][v * 1024 + k] : p.in[I_CCTX][k]; sS[i] = siluf_(x); }
    __syncthreads();
    float* mod = (float*)(p.ws + WS_MOD);
    for (int unit = blockIdx.x; unit < 192; unit += gridDim.x) {
        const int l = unit / 96, nb = (unit % 96) * 64;
        const float* W = p.in[I_WADA] + (size_t)l * 1024 * 6144 + nb + lane;
        float acc[9];
#pragma unroll
        for (int v = 0; v < 9; ++v) acc[v] = 0.f;
#pragma unroll 8
        for (int k = wave * 128; k < wave * 128 + 128; k += 4) {
            const float w0 = W[(size_t)k * 6144], w1 = W[(size_t)(k + 1) * 6144], w2 = W[(size_t)(k + 2) * 6144], w3 = W[(size_t)(k + 3) * 6144];
#pragma unroll
            for (int v = 0; v < 9; ++v) { const f32x4 s4 = *(const LAS f32x4*)(sS + v * 1024 + k); acc[v] += (s4.x * w0 + s4.y * w1) + (s4.z * w2 + s4.w * w3); } }
#pragma unroll
        for (int v = 0; v < 9; ++v) red[(wave * 9 + v) * 64 + lane] = acc[v];
        __syncthreads();
        for (int i = tid; i < 576; i += NTHREADS) { const int v = i >> 6, ln = i & 63; float s = 0.f;
#pragma unroll
            for (int w = 0; w < 8; ++w) s += red[(w * 9 + v) * 64 + ln];
            st4_wt(mod + (size_t)(l * 9 + v) * 6144 + nb + ln, s + p.in[I_BADA][l * 6144 + nb + ln]); }
        __syncthreads();
    }
    __syncthreads();
    LAS float* scr = (LAS float*)(L + wave * 16384);
    const int gw = blockIdx.x * NWAVES + wave, NGW = gridDim.x * NWAVES;
    constexpr int I_IN = 16 * 89, I_OUT = 16 * 32, I_M1 = 16 * 128, I_M2 = 64 * 32, I_LAYER = I_IN + I_OUT + I_M1 + I_M2;
    const bool bal = (gridDim.x == 256); const int bx = blockIdx.x;
    const int nmine = !bal ? (2 * I_LAYER + NGW - 1) / NGW : (bx >= 192 ? 11 : (bx < 36 ? 5 : 4));
    for (int j = 0; j < nmine; ++j) {
        int it;
        if (!bal) it = gw + j * NGW;
        else if (bx >= 192) it = (bx - 192) * 88 + wave * 11 + j;
        else it = j < 4 ? 5632 + bx * 32 + wave * 4 + j : 11776 + bx * 8 + wave;
        if (it >= 2 * I_LAYER) continue;
        const int l = it / I_LAYER; int r = it % I_LAYER;
        bf16_t* wt = (bf16_t*)(p.ws + WS_WT + (size_t)l * WT_LAYER);
        if (r < I_IN) { transpose_item<true>(p.in[I_WIN] + (size_t)l * 1024 * PIN, 1024, PIN, wt, scr, r, lane); continue; } r -= I_IN;
        if (r < I_OUT) { transpose_item<false>(p.in[I_WOUT] + (size_t)l * 1024 * 1024, 1024, 1024, (bf16_t*)((unsigned char*)wt + WT_OUT), scr, r, lane); continue; } r -= I_OUT;
        if (r < I_M1) { transpose_item<false>(p.in[I_W1] + (size_t)l * 1024 * FF, 1024, FF, (bf16_t*)((unsigned char*)wt + WT_W1), scr, r, lane); continue; } r -= I_M1;
        transpose_item<false>(p.in[I_W2] + (size_t)l * FF * 1024, FF, 1024, (bf16_t*)((unsigned char*)wt + WT_W2), scr, r, lane);
    }
}

__device__ __forceinline__ void normmod_phase(const Params& p, int l, int which) {
    const bool first = (which == 0 && l == 0);
    const float* xlat = p.in[I_X]; const float* xctx = p.in[I_CTX];
    const bf16_t* rlat = (const bf16_t*)p.out; const bf16_t* rctx = (const bf16_t*)(p.ws + WS_CTXRES);
    const int nrows = (l == 1 && which == 1) ? RL : RT;
    const float* g = (which == 0 ? p.in[I_GMIX] : p.in[I_GMLP]) + l * D; const float* modl = (const float*)(p.ws + WS_MOD) + (size_t)l * 9 * 6144;
    const int shi = which == 0 ? 0 : 3, sci = shi + 1;
    const int tid = tid_opaque(), lane = tid & 63, wave = tid >> 6;
    const int gw = blockIdx.x * NWAVES + wave, NGW = gridDim.x * NWAVES;
    bf16_t* XN = (bf16_t*)(p.ws + WS_XN);
    for (int row = gw; row < nrows; row += NGW) {
        const bool lat = row < RL; const int bsel = lat ? (row >> 11) : 8;
        const float* xr = lat ? xlat + (size_t)row * D : xctx + (size_t)(row - RL) * D;
        const bf16_t* xb = lat ? rlat + (size_t)row * D : rctx + (size_t)(row - RL) * D;
        const float* sh = modl + bsel * 6144 + shi * 1024; const float* sc = modl + bsel * 6144 + sci * 1024;
        f32x4 v[4]; float s = 0.f;
        const bool fold = (which == 0 && l == 1 && !lat);
#pragma unroll
        for (int j = 0; j < 4; ++j) { const int cj = 8 * lane + 512 * (j >> 1) + 4 * (j & 1);
            if (first) v[j] = *(const f32x4*)(xr + cj); else { const u32x2 t = *(const u32x2*)(xb + cj); v[j] = (f32x4){bf_lo(t.x), bf_hi(t.x), bf_lo(t.y), bf_hi(t.y)}; }
            if (fold) { const bf16_t* pt = (const bf16_t*)(p.ws + WS_PART) + (size_t)(row - RL) * D + cj;
                f32x4 a = *(const f32x4*)(p.in[I_B2] + cj);
#pragma unroll
                for (int ks = 0; ks < 4; ++ks) { const u32x2 t = *(const u32x2*)(pt + (size_t)ks * RC * D); a = a + (f32x4){bf_lo(t.x), bf_hi(t.x), bf_lo(t.y), bf_hi(t.y)}; }
                v[j] = v[j] + *(const f32x4*)((const float*)(p.ws + WS_MOD) + 8 * 6144 + 5 * 1024 + cj) * a; } s += (v[j].x * v[j].x + v[j].y * v[j].y) + (v[j].z * v[j].z + v[j].w * v[j].w); }
        const float rs = rsqrtf(wave_sum(s) * (1.f / D) + EPS);
#pragma unroll
        for (int h = 0; h < 2; ++h) { const int c = 8 * lane + 512 * h;
            const f32x4 g0 = *(const f32x4*)(g + c), g1 = *(const f32x4*)(g + c + 4), s0 = *(const f32x4*)(sh + c), s1 = *(const f32x4*)(sh + c + 4), c0 = *(const f32x4*)(sc + c), c1 = *(const f32x4*)(sc + c + 4);
            const f32x4 o0 = v[2 * h] * rs * g0 * (c0 + 1.f) + s0, o1 = v[2 * h + 1] * rs * g1 * (c1 + 1.f) + s1;
            u32x4 w; w.x = pk2(o0.x, o0.y); w.y = pk2(o0.z, o0.w); w.z = pk2(o1.x, o1.y); w.w = pk2(o1.z, o1.w);
            st16_wt(XN + (size_t)row * D + c, w); }
    }
}
__device__ __forceinline__ void final_phase(const Params& p) {
    const int tid = tid_opaque(), lane = tid & 63, wave = tid >> 6;
    const int gw = blockIdx.x * NWAVES + wave, NGW = gridDim.x * NWAVES;
    const float* g = p.in[I_GFIN]; const bf16_t* X = (const bf16_t*)(p.ws + WS_XN);
    for (int row = gw; row < RL; row += NGW) {
        const bf16_t* xb = X + (size_t)row * D; float* xr = p.out + (size_t)row * D;
        f32x4 v[4]; float s = 0.f;
#pragma unroll
        for (int j = 0; j < 4; ++j) { const u32x2 t = *(const u32x2*)(xb + 4 * lane + 256 * j); v[j] = (f32x4){bf_lo(t.x), bf_hi(t.x), bf_lo(t.y), bf_hi(t.y)}; s += (v[j].x * v[j].x + v[j].y * v[j].y) + (v[j].z * v[j].z + v[j].w * v[j].w); }
        const float rs = rsqrtf(wave_sum(s) * (1.f / D) + EPS);
#pragma unroll
        for (int j = 0; j < 4; ++j) { const int c = 4 * lane + 256 * j; const f32x4 gg = *(const f32x4*)(g + c); *(f32x4*)(xr + c) = v[j] * rs * gg; }
    }
}
__device__ __forceinline__ void finalize_phase(const Params& p, int l, int nrows) {
    const int tid = tid_opaque(), lane = tid & 63, wave = tid >> 6;
    const int gw = blockIdx.x * NWAVES + wave, NGW = gridDim.x * NWAVES;
    bf16_t* RF = (bf16_t*)(p.ws + WS_XN); const bf16_t* RB = (const bf16_t*)(p.ws + WS_RAWB); const bf16_t* P = (const bf16_t*)(p.ws + WS_PR);
    const float* gha = p.in[I_GHA] + l * 256; const float* gnb = p.in[I_GNB] + l * 512;
    for (int row = gw; row < nrows; row += NGW) {
        bf16_t* rf = RF + (size_t)row * D + 4 * lane; const bf16_t* rb = RB + (size_t)row * D + 4 * lane; const bf16_t* pr = P + (size_t)row * PRLD + 4 * lane;
        float v[4][4];
#pragma unroll
        for (int sgi = 0; sgi < 4; ++sgi) { const u32x2 a = *(const u32x2*)(rf + sgi * 256), b = *(const u32x2*)(rb + sgi * 256);
            v[sgi][0] = bf_lo(a.x) + bf_lo(b.x); v[sgi][1] = bf_hi(a.x) + bf_hi(b.x); v[sgi][2] = bf_lo(a.y) + bf_lo(b.y); v[sgi][3] = bf_hi(a.y) + bf_hi(b.y); }
        const u32x2 ov = *(const u32x2*)(pr + 256), z0 = *(const u32x2*)(pr + 512), z1 = *(const u32x2*)(pr + 768), gv = *(const u32x2*)(pr + 1024);
        { float s = v[0][0] * v[0][0] + v[0][1] * v[0][1] + v[0][2] * v[0][2] + v[0][3] * v[0][3];
#pragma unroll
          for (int o = 1; o < 16; o <<= 1) s += __shfl_xor(s, o);
          const float rs = rsqrtf(s * (1.f / 64.f) + EPS); const f32x4 gg = *(const f32x4*)(gha + 4 * lane);
          v[0][0] = v[0][0] * rs * gg.x * sigmoidf_(bf_lo(ov.x)); v[0][1] = v[0][1] * rs * gg.y * sigmoidf_(bf_hi(ov.x));
          v[0][2] = v[0][2] * rs * gg.z * sigmoidf_(bf_lo(ov.y)); v[0][3] = v[0][3] * rs * gg.w * sigmoidf_(bf_hi(ov.y)); }
        { v[1][0] *= siluf_(bf_lo(z0.x)); v[1][1] *= siluf_(bf_hi(z0.x)); v[1][2] *= siluf_(bf_lo(z0.y)); v[1][3] *= siluf_(bf_hi(z0.y));
          v[2][0] *= siluf_(bf_lo(z1.x)); v[2][1] *= siluf_(bf_hi(z1.x)); v[2][2] *= siluf_(bf_lo(z1.y)); v[2][3] *= siluf_(bf_hi(z1.y));
          float s = 0.f;
#pragma unroll
          for (int i = 0; i < 4; ++i) s += v[1][i] * v[1][i] + v[2][i] * v[2][i];
          const float rs = rsqrtf(wave_sum(s) * (1.f / 512.f) + EPS);
          const f32x4 g0 = *(const f32x4*)(gnb + 4 * lane), g1 = *(const f32x4*)(gnb + 256 + 4 * lane);
#pragma unroll
          for (int i = 0; i < 4; ++i) { v[1][i] = v[1][i] * rs * g0[i]; v[2][i] = v[2][i] * rs * g1[i]; } }
        { v[3][0] *= gelu_tanh(bf_lo(gv.x)); v[3][1] *= gelu_tanh(bf_hi(gv.x)); v[3][2] *= gelu_tanh(bf_lo(gv.y)); v[3][3] *= gelu_tanh(bf_hi(gv.y)); }
#pragma unroll
        for (int sgi = 0; sgi < 4; ++sgi) { u32x2 w; w.x = pk2(v[sgi][0], v[sgi][1]); w.y = pk2(v[sgi][2], v[sgi][3]); st8_wt(rf + sgi * 256, w); }
    }
}

__device__ __forceinline__ void conv_phase(const Params& p, LAS unsigned char* L, int l) {
    const int tid = tid_opaque();
    if (tid >= 480) return;
    const int stream = tid / 96, cgp = tid - 96 * stream, c0 = cgp * 16;
    float w[5][16];
#pragma unroll
    for (int j = 0; j < 5; ++j)
#pragma unroll
        for (int i = 0; i < 16; ++i) { const int c = c0 + i; float v;
            if (c0 < 512) v = j < 4 ? p.in[I_CAW][(l * 4 + j) * 512 + c] : p.in[I_CAB][l * 512 + c];
            else if (c0 < 1280) v = j < 4 ? p.in[I_CBW][(l * 4 + j) * 768 + (c - 512)] : p.in[I_CBB][l * 768 + (c - 512)];
            else v = j < 4 ? p.in[I_CCW][(l * 4 + j) * 256 + (c - 1280)] : p.in[I_CCB][l * 256 + (c - 1280)];
            w[j][i] = v; }
    const bf16_t* PA = (const bf16_t*)(p.ws + WS_PA); bf16_t* CV = (bf16_t*)(p.ws + WS_CV);
    const bool act = c0 < 1280; const float qs = c0 < 256 ? 0.125f : 1.f;
    for (int it = blockIdx.x; it < 461; it += gridDim.x) {
        const int seg = 5 * it + stream; if (seg >= 2304) break;
        const bool lat = seg < 2048; const int sb = lat ? seg : seg - 2048;
        const int bb = lat ? (sb >> 8) : (sb >> 5), pf0 = (lat ? (sb & 255) : (sb & 31)) * 8;
        const int Lseg = lat ? SEQL : CTXL, base = lat ? bb * SEQL : RL + bb * CTXL;
        const bool cm = lat && !act;
        u32x4 x[11][2];
#pragma unroll
        for (int r = 0; r < 11; ++r) { const int pj = pf0 + r - 2; const bool ok = (pj >= 0) && (pj < Lseg); const int pq = ok ? pj : pf0;
            const int tj = cm ? ((pq & 31) * 64 + (pq >> 5)) : pq; const bf16_t* rp = PA + (size_t)(base + tj) * PALD + c0;
            x[r][0] = *(const u32x4*)(rp); x[r][1] = *(const u32x4*)(rp + 8);
            if (!ok) { x[r][0] = (u32x4){0u, 0u, 0u, 0u}; x[r][1] = x[r][0]; } }
#pragma unroll
        for (int o = 0; o < 8; ++o) {
            const int pq = pf0 + o; const int tj = cm ? ((pq & 31) * 64 + (pq >> 5)) : pq;
#pragma unroll
            for (int hh = 0; hh < 2; ++hh) {
                float v[8];
#pragma unroll
                for (int i = 0; i < 8; ++i) v[i] = w[4][8 * hh + i];
#pragma unroll
                for (int j = 0; j < 4; ++j) { const u32x4 x_ = x[o + j][hh];
                    v[0] += w[j][8 * hh + 0] * bf_lo(x_.x); v[1] += w[j][8 * hh + 1] * bf_hi(x_.x); v[2] += w[j][8 * hh + 2] * bf_lo(x_.y); v[3] += w[j][8 * hh + 3] * bf_hi(x_.y);
                    v[4] += w[j][8 * hh + 4] * bf_lo(x_.z); v[5] += w[j][8 * hh + 5] * bf_hi(x_.z); v[6] += w[j][8 * hh + 6] * bf_lo(x_.w); v[7] += w[j][8 * hh + 7] * bf_hi(x_.w); }
                if (act) {
#pragma unroll
                    for (int i = 0; i < 8; ++i) v[i] = siluf_(v[i]) * qs;
                }
                u32x4 wv; wv.x = pk2(v[0], v[1]); wv.y = pk2(v[2], v[3]); wv.z = pk2(v[4], v[5]); wv.w = pk2(v[6], v[7]);
                st16_wt(CV + (size_t)(base + tj) * PALD + c0 + 8 * hh, wv);
            }
        }
    }
}

template <int MODE>
__device__ __forceinline__ void seq_unit(const Params& p, LAS unsigned char* L, int l, int b, int hd, int d) {
    const int tid = tid_opaque(), lane = tid & 63, wave = __builtin_amdgcn_readfirstlane(tid >> 6);
    const int r16 = lane & 15, q4 = lane >> 4;
    const int wpar = wave & 1, w8 = (wave >> 1) * 16;
    constexpr int OB = 40960, LSV = 88;
    LAS bf16_t* sS = (LAS bf16_t*)(L + 81920); LAS bf16_t* sC = (LAS bf16_t*)(L + 91136);
    LAS float* tabG = (LAS float*)(L + 114176); LAS float* tabM = (LAS float*)(L + 123392); LAS float* tabB = (LAS float*)(L + 132608);
    LAS bf16_t* sO = (LAS bf16_t*)(L + 142336);
    LAS float* rden = (LAS float*)(L + 141824);
    const bf16_t* CV = (const bf16_t*)(p.ws + WS_CV);
    const float* G = (const float*)(p.ws + WS_GATES);
    bf16_t* outp = (bf16_t*)(p.ws + (d ? WS_RAWB : WS_XN));
    const bf16_t* P2; int ld2;
    int col0, col1, col2, ocol, gc0, gc1 = 0; float gb0, gb1 = 0.f, Aneg = 0.f, dskip = 0.f;
    if (MODE == 0) { col0 = hd * 64; col1 = 256 + hd * 64; col2 = hd * 64; P2 = (const bf16_t*)(p.ws + WS_PR); ld2 = PRLD; ocol = hd * 64; gc0 = d * 4 + hd; gc1 = 8 + d * 4 + hd;
        gb0 = p.in[I_BIG][(l * 2 + d) * 4 + hd]; gb1 = p.in[I_BFG][(l * 2 + d) * 4 + hd]; }
    else { const int g = hd >> 2; col0 = 1152 + g * 64; col1 = 1024 + g * 64; col2 = 512 + hd * 64; P2 = CV; ld2 = PALD; ocol = 256 + hd * 64; gc0 = 16 + d * 8 + hd;
        gb0 = p.in[I_DTB][(l * 2 + d) * 8 + hd]; Aneg = -__expf(p.in[I_ALOG][(l * 2 + d) * 8 + hd]); dskip = p.in[I_DSKIP][l * 8 + hd]; }
    __syncthreads();
    for (int i = tid; i < 80 * LS / 2; i += NTHREADS) ((LAS unsigned*)sC)[i] = 0u;
    if (MODE == 0 && tid < 128) { LAS unsigned char* ob = L + (tid >> 6) * OB; const int row = tid & 63;
        unsigned z_ = 0u, o_ = 0x00003F80u; asm volatile("" : "+v"(z_), "+v"(o_));
        const u32x4 zz_ = {z_, z_, z_, z_}, oo_ = {o_, z_, z_, z_};
        *(LAS u32x4*)(ob + 18432 + (row * LSV + 64) * 2) = oo_; *(LAS u32x4*)(ob + 18432 + (row * LSV + 72) * 2) = zz_;
        *(LAS u32x4*)(ob + 29696 + (row * LSV + 64) * 2) = zz_; *(LAS u32x4*)(ob + 29696 + (row * LSV + 72) * 2) = zz_; }
    for (int c = wave; c < 36; c += 8) {
        const bool isctx = c < 4; const int cc = isctx ? c : c - 4; const int Lseg = isctx ? CTXL : SEQL; const int base = isctx ? RL + b * CTXL : b * SEQL;
        const int pos0 = cc * 64 + lane; const int tau0 = d ? Lseg - 1 - pos0 : pos0; const float* gp = G + (size_t)(base + tau0) * 32;
        if (MODE == 0) {
            const float ig = gp[gc0] + gb0, fg = gp[gc1] + gb1;
            const float lf = fminf(fg, 0.f) - log1pf(__expf(-fabsf(fg)));
            float bs = lf;
#pragma unroll
            for (int o = 1; o < 64; o <<= 1) { const float t = __shfl_up(bs, o); if (lane >= o) bs += t; }
            const float g = ig - bs; float M = g;
#pragma unroll
            for (int o = 1; o < 64; o <<= 1) { const float t = __shfl_up(M, o); if (lane >= o) M = fmaxf(M, t); }
            tabG[c * 64 + lane] = g; tabM[c * 64 + lane] = M; tabB[c * 64 + lane] = bs;
        } else {
            const float dtv = softplusf_(gp[gc0] + gb0);
            float cs = dtv * Aneg;
#pragma unroll
            for (int o = 1; o < 64; o <<= 1) { const float t = __shfl_up(cs, o); if (lane >= o) cs += t; }
            tabG[c * 64 + lane] = cs; tabM[c * 64 + lane] = dtv;
        }
    }
    f32x4 st[2] = {{0.f, 0.f, 0.f, 0.f}, {0.f, 0.f, 0.f, 0.f}};
    f32x4 stx = {0.f, 0.f, 0.f, 0.f};
    f32x4 res[2] = {{0.f, 0.f, 0.f, 0.f}, {0.f, 0.f, 0.f, 0.f}};
    float m_in = 0.f;
    u32x4 r0, r1, r2, r3, r4, r5;
#define PREFETCH(CN) do { const int cn_ = (CN); const bool isctx_ = cn_ < 4; const int cc_ = isctx_ ? cn_ : cn_ - 4; const int Lseg_ = isctx_ ? CTXL : SEQL; const int base_ = isctx_ ? RL + b * CTXL : b * SEQL; \
        const int pos_ = cc_ * 64 + lane; const int row_ = base_ + (d ? Lseg_ - 1 - pos_ : pos_); \
        r0 = *(const u32x4*)(CV + (size_t)row_ * PALD + col0 + w8); r1 = *(const u32x4*)(CV + (size_t)row_ * PALD + col1 + w8); r2 = *(const u32x4*)(P2 + (size_t)row_ * ld2 + col2 + w8); \
        r3 = *(const u32x4*)(CV + (size_t)row_ * PALD + col0 + w8 + 8); r4 = *(const u32x4*)(CV + (size_t)row_ * PALD + col1 + w8 + 8); r5 = *(const u32x4*)(P2 + (size_t)row_ * ld2 + col2 + w8 + 8); } while (0)
#define WRITEOUT(CP) do { const int cp_ = (CP); const bool isctx_ = cp_ < 4; const int cc_ = isctx_ ? cp_ : cp_ - 4; const int Lseg_ = isctx_ ? CTXL : SEQL; const int base_ = isctx_ ? RL + b * CTXL : b * SEQL; \
        const int tok_ = tid >> 3, grp_ = (tid & 7) * 8; const int pos_ = cc_ * 64 + tok_; const int row_ = base_ + (d ? Lseg_ - 1 - pos_ : pos_); \
        st16_wt(outp + (size_t)row_ * D + ocol + grp_, *(const LAS u32x4*)(sO + tok_ * LS + grp_)); } while (0)
    r0 = r1 = r2 = r3 = r4 = r5 = (u32x4){0u, 0u, 0u, 0u};
    if (wpar == 0) PREFETCH(0); else PREFETCH(1);
    __syncthreads();
    for (int c = -1; c < 36; ++c) {
        const int cur = c & 1;
        LAS unsigned char* Oc = L + cur * OB; LAS unsigned char* On = L + (cur ^ 1) * OB;
        LAS bf16_t* sQ = (LAS bf16_t*)Oc; LAS bf16_t* sK = (LAS bf16_t*)(Oc + 9216); LAS bf16_t* sV = (LAS bf16_t*)(Oc + 18432); LAS bf16_t* sWV = (LAS bf16_t*)(Oc + 29696);
        const LAS float* tg = tabG + (c < 0 ? 0 : c) * 64; const LAS float* tm = tabM + (c < 0 ? 0 : c) * 64; const LAS float* tb = tabB + (c < 0 ? 0 : c) * 64;
        float m_out = 0.f, decay = 1.f;
        if (c >= 0) {
            if (MODE == 0) { const float mm_end = fmaxf(m_in, tm[63]); decay = __expf(m_in - mm_end); m_out = tb[63] + mm_end; }
            else decay = __expf(tg[63]);
#pragma unroll
            for (int i = 0; i < 2; ++i) { const int idx = wave + 8 * i, stile = idx >> 2, ttile = idx & 3;
                f32x4 acc = {0.f, 0.f, 0.f, 0.f}; acc = mma64(sK + stile * 16 * LS, sQ + ttile * 16 * LS, lane, acc);
                const int t = ttile * 16 + r16, s0 = stile * 16 + 4 * q4;
                const float bt = (MODE == 0) ? -fmaxf(m_in, tm[t]) : tg[t];
                float o[4];
#pragma unroll
                for (int j = 0; j < 4; ++j) { const int s = s0 + j;
                    const float e = (MODE == 0) ? __expf(tg[s] + bt) : __expf(bt - tg[s]) * tm[s];
                    o[j] = (s <= t) ? acc[j] * e : 0.f; }
                u32x2 w; w.x = pk2(o[0], o[1]); w.y = pk2(o[2], o[3]); *(LAS u32x2*)(sS + t * LS + s0) = w; }
        }
        LDS_BARRIER();
        if (c >= 1) WRITEOUT(c - 1);
        if (c >= 0) {
            LAS bf16_t* sCc = sC + cur * 80 * LS; LAS bf16_t* sCn = sC + (cur ^ 1) * 80 * LS;
#pragma unroll
            for (int i = 0; i < 2; ++i) { const int idx = wave + 8 * i, vtile = idx >> 2, ttile = idx & 3; const int t = ttile * 16 + r16;
                f32x4 a = {0.f, 0.f, 0.f, 0.f}; a = mma64(sCc + vtile * 16 * LS, sQ + ttile * 16 * LS, lane, a);
                const float dl = (MODE == 0) ? __expf(m_in - fmaxf(m_in, tm[t])) : __expf(tg[t]);
                a = a * dl;
#pragma unroll
                for (int kk = 0; kk < 2; ++kk) { const bf16x8 fa = tr_frag(sV, LSV, vtile, kk, lane); const bf16x8 fb = *(const LAS bf16x8*)(sS + (ttile * 16 + r16) * LS + kk * 32 + q4 * 8);
                    a = __builtin_amdgcn_mfma_f32_16x16x32_bf16(fa, fb, a, 0, 0, 0); }
                res[i] = a; }
            if (MODE == 0 && wave < 4) { const int t = wave * 16 + r16;
                f32x4 a = {0.f, 0.f, 0.f, 0.f}; a = mma64(sCc + 64 * LS, sQ + wave * 16 * LS, lane, a);
                a = a * __expf(m_in - fmaxf(m_in, tm[t]));
#pragma unroll
                for (int kk = 0; kk < 2; ++kk) { const bf16x8 fa = tr_frag(sV, LSV, 4, kk, lane); const bf16x8 fb = *(const LAS bf16x8*)(sS + (wave * 16 + r16) * LS + kk * 32 + q4 * 8);
                    a = __builtin_amdgcn_mfma_f32_16x16x32_bf16(fa, fb, a, 0, 0, 0); }
                if (q4 == 0) rden[t] = a[0]; }
#pragma unroll
            for (int i = 0; i < 2; ++i) { const int idx = wave + 8 * i, ktile = idx >> 2, vtile = idx & 3;
                f32x4 a = st[i] * decay;
#pragma unroll
                for (int kk = 0; kk < 2; ++kk) { const bf16x8 fa = tr_frag(sK, LS, ktile, kk, lane); const bf16x8 fb = tr_frag(sWV, LSV, vtile, kk, lane);
                    a = __builtin_amdgcn_mfma_f32_16x16x32_bf16(fa, fb, a, 0, 0, 0); }
                st[i] = a;
                u32x2 w; w.x = pk2(a[0], a[1]); w.y = pk2(a[2], a[3]); *(LAS u32x2*)(sCn + (vtile * 16 + r16) * LS + ktile * 16 + 4 * q4) = w; }
            if (MODE == 0 && wave >= 4) { const int ktile = wave - 4;
                f32x4 a = stx * decay;
#pragma unroll
                for (int kk = 0; kk < 2; ++kk) { const bf16x8 fa = tr_frag(sK, LS, ktile, kk, lane); const bf16x8 fb = tr_frag(sWV, LSV, 4, kk, lane);
                    a = __builtin_amdgcn_mfma_f32_16x16x32_bf16(fa, fb, a, 0, 0, 0); }
                stx = a;
                u32x2 w; w.x = pk2(a[0], a[1]); w.y = pk2(a[2], a[3]); *(LAS u32x2*)(sCn + (64 + r16) * LS + ktile * 16 + 4 * q4) = w; }
        }
        if (c + 1 < 36 && ((c + 1) & 1) == wpar) {
            const int cn = c + 1;
            LAS bf16_t* nQ = (LAS bf16_t*)On; LAS bf16_t* nK = (LAS bf16_t*)(On + 9216); LAS bf16_t* nV = (LAS bf16_t*)(On + 18432); LAS bf16_t* nWV = (LAS bf16_t*)(On + 29696);
            float om;
            if (MODE == 0) om = __expf(tabG[cn * 64 + lane] - fmaxf(m_out, tabM[cn * 64 + 63]));
            else om = __expf(tabG[cn * 64 + 63] - tabG[cn * 64 + lane]) * tabM[cn * 64 + lane];
            if (MODE == 0 && (wave >> 1) == 0) nWV[lane * LSV + 64] = (bf16_t)f2bf(om);
            *(LAS u32x4*)(nQ + lane * LS + w8) = r0; *(LAS u32x4*)(nQ + lane * LS + w8 + 8) = r3;
            *(LAS u32x4*)(nK + lane * LS + w8) = r1; *(LAS u32x4*)(nK + lane * LS + w8 + 8) = r4;
            *(LAS u32x4*)(nV + lane * LSV + w8) = r2; *(LAS u32x4*)(nV + lane * LSV + w8 + 8) = r5;
            { u32x4 wv; wv.x = pk2(bf_lo(r2.x) * om, bf_hi(r2.x) * om); wv.y = pk2(bf_lo(r2.y) * om, bf_hi(r2.y) * om); wv.z = pk2(bf_lo(r2.z) * om, bf_hi(r2.z) * om); wv.w = pk2(bf_lo(r2.w) * om, bf_hi(r2.w) * om);
              *(LAS u32x4*)(nWV + lane * LSV + w8) = wv;
              wv.x = pk2(bf_lo(r5.x) * om, bf_hi(r5.x) * om); wv.y = pk2(bf_lo(r5.y) * om, bf_hi(r5.y) * om); wv.z = pk2(bf_lo(r5.z) * om, bf_hi(r5.z) * om); wv.w = pk2(bf_lo(r5.w) * om, bf_hi(r5.w) * om);
              *(LAS u32x4*)(nWV + lane * LSV + w8 + 8) = wv; }
            if (c + 3 < 36) PREFETCH(c + 3);
        }
        LDS_BARRIER();
        if (c >= 0) {
            const bool isctx = c < 4; const int cc = isctx ? c : c - 4; const int Lseg = isctx ? CTXL : SEQL; const int base = isctx ? RL + b * CTXL : b * SEQL;
#pragma unroll
            for (int i = 0; i < 2; ++i) { const int idx = wave + 8 * i, vtile = idx >> 2, ttile = idx & 3; const int t = ttile * 16 + r16, v0 = vtile * 16 + 4 * q4;
                f32x4 a = res[i];
                if (MODE == 0) { const float mmt = fmaxf(m_in, tm[t]); const float dn = rden[t]; a = a * __builtin_amdgcn_rcpf(fmaxf(fabsf(dn), __expf(-(tb[t] + mmt)))); }
                else if (d == 0) {
#pragma unroll
                    for (int j = 0; j < 1; ++j) { const u32x2 xv = *(const LAS u32x2*)(sV + t * LSV + v0); a[0] += dskip * bf_lo(xv.x); a[1] += dskip * bf_hi(xv.x); a[2] += dskip * bf_lo(xv.y); a[3] += dskip * bf_hi(xv.y); } }
                u32x2 w; w.x = pk2(a[0], a[1]); w.y = pk2(a[2], a[3]);
                *(LAS u32x2*)(sO + t * LS + v0) = w; }
        }
        m_in = m_out;
    }
    LDS_BARRIER();
    WRITEOUT(35);
#undef WRITEOUT
#undef PREFETCH
}

__device__ __forceinline__ void rg_unit(const Params& p, LAS unsigned char* L, int l, int b, int n, int d) {
    const int tid = tid_opaque(), lane = tid & 63, wave = __builtin_amdgcn_readfirstlane(tid >> 6);
    const int tt = tid >> 3, cg8 = (tid & 7) * 8, r16 = lane & 15, q4 = lane >> 4;
    LAS bf16_t* sXb = (LAS bf16_t*)(L + 0); LAS bf16_t* sWt = (LAS bf16_t*)(L + 9216);
    LAS float* sXf = (LAS float*)(L + 27648); LAS float* sA = (LAS float*)(L + 44288); LAS float* sU = (LAS float*)(L + 60928); LAS float* sH = (LAS float*)(L + 77568);
    LAS float* sv = (LAS float*)(L + 95488);
    LAS float* sSeg = (LAS float*)(L + 96256);
    const bf16_t* CV = (const bf16_t*)(p.ws + WS_CV);
    bf16_t* outp = (bf16_t*)(p.ws + (d ? WS_RAWB : WS_XN));
    __syncthreads();
    for (int i = tid; i < 2 * 64 * 64; i += NTHREADS) { const int g = i >> 12, c = (i >> 6) & 63, dd = i & 63;
        const float v = p.in[I_WRG][((size_t)((((l * 2 + d) * 2 + g) * 4 + n) * 64 + c)) * 64 + dd]; sWt[(g * 64 + dd) * LS + c] = (bf16_t)f2bf(v); }
    if (tid < 64) { sv[tid] = p.in[I_BRG][((l * 2 + d) * 2 + 0) * 256 + n * 64 + tid]; sv[64 + tid] = p.in[I_BRG][((l * 2 + d) * 2 + 1) * 256 + n * 64 + tid];
        sv[128 + tid] = softplusf_(-p.in[I_LAM][(l * 2 + d) * 256 + n * 64 + tid]); }
    float hstate = 0.f;
    u32x4 rx = {0u, 0u, 0u, 0u};
    for (int c = -1; c < 36; ++c) {
        if (c >= 0) {
            float v[8] = {bf_lo(rx.x), bf_hi(rx.x), bf_lo(rx.y), bf_hi(rx.y), bf_lo(rx.z), bf_hi(rx.z), bf_lo(rx.w), bf_hi(rx.w)};
            *(LAS u32x4*)(sXb + tt * LS + cg8) = rx;
#pragma unroll
            for (int i = 0; i < 8; ++i) sXf[tt * 65 + cg8 + i] = v[i];
            LDS_BARRIER();
        }
        if (c + 1 < 36) {
            const int cn = c + 1; const bool isctx = cn < 4; const int cc = isctx ? cn : cn - 4; const int Lseg = isctx ? CTXL : SEQL;
            const int pos = cc * 64 + tt; const int pf = d ? Lseg - 1 - pos : pos;
            const int row = isctx ? RL + b * CTXL + pf : b * SEQL + (pf & 31) * 64 + (pf >> 5);
            rx = *(const u32x4*)(CV + (size_t)row * PALD + 1280 + n * 64 + cg8);
        }
        if (c >= 0) {
            { const int jt = wave & 3, dp = wave >> 2;
#pragma unroll
              for (int i = 0; i < 2; ++i) { const int dtile = 2 * dp + i;
                  f32x4 a0 = {0.f, 0.f, 0.f, 0.f}, a1 = {0.f, 0.f, 0.f, 0.f};
                  a0 = mma64(sXb + jt * 16 * LS, sWt + (dtile * 16) * LS, lane, a0);
                  a1 = mma64(sXb + jt * 16 * LS, sWt + (64 + dtile * 16) * LS, lane, a1);
                  const int dd = dtile * 16 + r16, j0 = jt * 16 + 4 * q4; const float br = sv[dd], bi = sv[64 + dd], sp = sv[128 + dd];
#pragma unroll
                  for (int jj = 0; jj < 4; ++jj) { const float rr = sigmoidf_(a0[jj] + br), ii = sigmoidf_(a1[jj] + bi); const float la = -8.f * rr * sp;
                      const float a = __expf(la); const float u = __builtin_amdgcn_sqrtf(fmaxf(1.f - a * a, 0.f)) * ii * sXf[(j0 + jj) * 65 + dd];
                      sA[(j0 + jj) * 65 + dd] = a; sU[(j0 + jj) * 65 + dd] = u; } } }
            LDS_BARRIER();
            { float pp[8], uu[8]; float P = 1.f, U = 0.f;
#pragma unroll
              for (int j = 0; j < 8; ++j) { const float a = sA[(wave * 8 + j) * 65 + lane], u = sU[(wave * 8 + j) * 65 + lane]; P = a * P; U = a * U + u; pp[j] = P; uu[j] = U; }
              sSeg[wave * 64 + lane] = P; sSeg[512 + wave * 64 + lane] = U;
              LDS_BARRIER();
              float h = hstate, hin = hstate;
#pragma unroll
              for (int s = 0; s < 8; ++s) { if (s == wave) hin = h; h = sSeg[s * 64 + lane] * h + sSeg[512 + s * 64 + lane]; }
              hstate = h;
#pragma unroll
              for (int j = 0; j < 8; ++j) sH[(wave * 8 + j) * 65 + lane] = pp[j] * hin + uu[j]; }
            LDS_BARRIER();
            { const bool isctx = c < 4; const int cc = isctx ? c : c - 4; const int Lseg = isctx ? CTXL : SEQL;
              const int pos = cc * 64 + tt; const int pf = d ? Lseg - 1 - pos : pos;
              const int row = isctx ? RL + b * CTXL + pf : b * SEQL + (pf & 31) * 64 + (pf >> 5);
              const LAS float* hp = sH + tt * 65 + cg8;
              u32x4 w; w.x = pk2(hp[0], hp[1]); w.y = pk2(hp[2], hp[3]); w.z = pk2(hp[4], hp[5]); w.w = pk2(hp[6], hp[7]);
              st16_wt(outp + (size_t)row * D + 768 + n * 64 + cg8, w); }
        }
    }
}
__device__ __forceinline__ void scan_phase(const Params& p, LAS unsigned char* L, int l) {
    for (int u = blockIdx.x; u < 256; u += gridDim.x) {
        if (u < 64) seq_unit<0>(p, L, l, u >> 3, (u & 7) >> 1, u & 1);
        else if (u < 192) { const int v = u - 64; seq_unit<1>(p, L, l, v >> 4, (v & 15) >> 1, v & 1); }
        else { const int v = u - 192; rg_unit(p, L, l, v >> 3, (v & 7) >> 1, v & 1); }
    }
}

__global__ void __launch_bounds__(NTHREADS, 2) fwd_kernel(Params p) {
    extern __shared__ __attribute__((aligned(16))) unsigned char lds_raw[];
    LAS unsigned char* L = (LAS unsigned char*)lds_raw;
    if (threadIdx.x < 4) ((LAS unsigned*)(L + LDS_BARST))[threadIdx.x] = 0u;
    __syncthreads();
    (void)xcd_barrier_post((unsigned*)(p.ws + WS_CTL), (volatile LAS unsigned*)(L + LDS_BARST));
#pragma unroll 1
    for (int ph = p.lo; ph < p.hi; ++ph) {
        Params pl = p; { unsigned char* w_ = pl.ws; asm volatile("" : "+s"(w_)); pl.ws = w_; }
        if (ph == 0) phase0(pl, L);
        else if (ph == NPHASES - 1) final_phase(pl);
        else {
            const int l = (ph - 1) / 10, k = (ph - 1) - 10 * l;
            if (k == 9 && l == 1) continue;
            if (k == 0) normmod_phase(pl, l, 0);
            else if (k == 6) normmod_phase(pl, l, 1);
            else if (k == 2) conv_phase(pl, L, l);
            else if (k == 3) scan_phase(pl, L, l);
            else if (k == 4) finalize_phase(pl, l, l == 0 ? RT : RL);
            else {
                const unsigned char* wt = pl.ws + WS_WT + (size_t)l * WT_LAYER;
                const int Mrest = l == 0 ? RT : RL;
                pg8::Gemm g; EpiAll E; E.pp = &pl; E.l = l; Order S; S.nslice = 0;
                if (k == 1)      { g.A = (const pg8::bf16_t*)(pl.ws + WS_XN); g.Bt = (const pg8::bf16_t*)wt;            g.M = RT;    g.N = PINP; g.K = D;  g.ld = D;  E.kind = 0; }
                else if (k == 5) { g.A = (const pg8::bf16_t*)(pl.ws + WS_XN); g.Bt = (const pg8::bf16_t*)(wt + WT_OUT); g.M = Mrest; g.N = D;    g.K = D;  g.ld = D;  E.kind = 1; }
                else if (k == 7) { g.A = (const pg8::bf16_t*)(pl.ws + WS_XN); g.Bt = (const pg8::bf16_t*)(wt + WT_W1);  g.M = Mrest; g.N = FF;   g.K = D;  g.ld = D;  E.kind = 2; }
                else if (k == 8) { g.A = (const pg8::bf16_t*)(pl.ws + WS_H);  g.Bt = (const pg8::bf16_t*)(wt + WT_W2);  g.M = RL;    g.N = D;    g.K = FF; g.ld = FF; E.kind = 3; }
                else             { g.A = (const pg8::bf16_t*)(pl.ws + WS_H) + (size_t)RL * FF; g.Bt = (const pg8::bf16_t*)(wt + WT_W2); g.M = RC; g.N = D; g.K = FF / 4; g.ld = FF; E.kind = 4; S.nslice = 4; }
                S.so.init(g.M, g.N, (int)gridDim.x, (int)blockIdx.x);
                pg8::gemm_phase<EpiAll, Order, true, true>(L, g, S, E);
            }
        }
        if (ph + 1 < p.hi) { XcdBarrier bar; bar.bar = (unsigned*)(pl.ws + WS_CTL); bar.x = xb_xcc_id(); bar.st = (volatile LAS unsigned*)(L + LDS_BARST); xcd_barrier(bar); }
    }
}

extern "C" void kernel_launch(void* const* d_in, const int* in_sizes, int n_in, void* d_out, int out_size, void* d_ws, size_t ws_size, hipStream_t stream) {
    static int grid = 0;
    if (grid == 0) {
        if (n_in != 31 || out_size != RL * D || ws_size < WS_END) { fprintf(stderr, "kernel_launch: unexpected problem (n_in %d out %d ws %zu)\n", n_in, out_size, ws_size); grid = -1; return; }
        int dev = 0, cus = 0, per_cu = 0;
        (void)hipGetDevice(&dev); (void)hipDeviceGetAttribute(&cus, hipDeviceAttributeMultiprocessorCount, dev);
        if (hipFuncSetAttribute((const void*)fwd_kernel, hipFuncAttributeMaxDynamicSharedMemorySize, LDS_BYTES) != hipSuccess) { fprintf(stderr, "kernel_launch: hipFuncSetAttribute failed\n"); grid = -1; return; }
        if (hipOccupancyMaxActiveBlocksPerMultiprocessor(&per_cu, (const void*)fwd_kernel, NTHREADS, LDS_BYTES) != hipSuccess || per_cu < 1) { fprintf(stderr, "kernel_launch: occupancy query says %d\n", per_cu); per_cu = 1; }
        (void)hipGetLastError();
        if (per_cu > 1) per_cu = 1;
        grid = cus * per_cu;
        if (grid > 256) grid = 256;
    }
    if (grid < 0) return;
    Params p{};
    for (int i = 0; i < 31; ++i) p.in[i] = (const float*)d_in[i];
    p.out = (float*)d_out; p.ws = (unsigned char*)d_ws;
    (void)hipMemsetAsync((unsigned char*)d_ws + WS_CTL, 0, CTL_BYTES, stream);
#if MK_N_LAUNCHES == 1
    p.lo = 0; p.hi = NPHASES;
    hipLaunchKernelGGL(fwd_kernel, dim3(grid), dim3(NTHREADS), LDS_BYTES, stream, p);
    hipError_t e = hipPeekAtLastError();
    if (e != hipSuccess) fprintf(stderr, "launch failed: %s (grid %d)\n", hipGetErrorString(e), grid);
#else
    for (int k = 0; k < NPHASES; ++k) { p.lo = k; p.hi = k + 1; hipLaunchKernelGGL(fwd_kernel, dim3(grid), dim3(NTHREADS), LDS_BYTES, stream, p); }
#endif
}
```

```cpp
#include <hip/hip_runtime.h>
#include <hip/hip_cooperative_groups.h>
#include <cstdio>
#include <cstdint>
namespace cg = cooperative_groups;
__device__ __forceinline__ int tid_opaque() { int t = threadIdx.x; asm volatile("" : "+v"(t)); return t; }
namespace pg8 {
#define PG8_LAS __attribute__((address_space(3)))
typedef unsigned short bf16_t;
typedef short bf16x8 __attribute__((ext_vector_type(8)));
typedef float f32x4 __attribute__((ext_vector_type(4)));
typedef unsigned u32x4 __attribute__((ext_vector_type(4)));
constexpr int BM = 256, BK = 64, HALF = 128, HTB = HALF * BK * 2  , STAGE_BYTES = 8 * HTB, NXCD = 8, WGM = 8;

__host__ __device__ __forceinline__ int lds_byte(int r, int c) { const int st = (r >> 4) * 2 + (c >> 5), rr = r & 15, cc = c & 31, ob = rr * 64 + cc * 2; return st * 1024 + (ob ^ (((ob >> 9) & 1) << 5)); }
__host__ __device__ __forceinline__ void stage_rc(int b, int& R, int& C) { const int st = b / 1024, sb = b % 1024, swz = sb ^ (((sb >> 9) & 1) << 5); R = (st >> 1) * 16 + swz / 64; C = (st & 1) * 32 + (swz % 64) / 2; }
__host__ __device__ __forceinline__ int perm32(int rho) { const int n = rho >> 4, i = rho & 15; return 8 * (i >> 2) + 4 * n + (i & 3); }

struct Unit { int pm, pn, ks; };
struct Gemm { const bf16_t* A; const bf16_t* Bt; int M, N, K, ld; };

struct StaticOrder {
    int nM, nN, nwg, G, c;
    __host__ __device__ void init(int M, int N, int G_, int c_) { nM = M / BM; nN = N / BM; nwg = nM * nN; G = G_; c = c_; }
    __host__ __device__ bool next(int i, Unit& u) const {
        const long L = (long)i * G + c; if (L >= nwg) return false;
        int wgid = (int)L; { const int q = nwg / NXCD, r = nwg % NXCD, xcd = wgid % NXCD, off = wgid / NXCD; wgid = (xcd < r ? xcd * (q + 1) : r * (q + 1) + (xcd - r) * q) + off; }
        const int nig = WGM * nN, gid = wgid / nig, fm = gid * WGM, gsz = (nM - fm) < WGM ? (nM - fm) : WGM;
        u.pm = fm + ((wgid % nig) % gsz); u.pn = (wgid % nig) / gsz; u.ks = 0; return true;
    }
    __device__ __forceinline__ void a_ready(const Unit&) const {}
    __device__ __forceinline__ void done(const Unit&) const {}
};

__device__ __forceinline__ unsigned cvt_pk_bf16(float lo, float hi) { unsigned r; asm volatile("v_cvt_pk_bf16_f32 %0, %1, %2" : "=v"(r) : "v"(lo), "v"(hi)); return r; }
typedef float f32x2 __attribute__((ext_vector_type(2)));
template <class Epi, class Sched, bool ALIGN_EPI = false, bool SP2 = false>
__device__ __forceinline__ void gemm_phase(PG8_LAS unsigned char* lds, const Gemm g, const Sched& S, const Epi& E) {
    const int tid = tid_opaque(), wid = __builtin_amdgcn_readfirstlane(tid >> 6), lane = tid & 63, wr = wid >> 2, wc = wid & 3, fr = lane & 15, fq = lane >> 4;
    const int K = g.K, nt = K / BK, ld = g.ld;
    unsigned voffA[2], voffB[2];
#pragma unroll
    for (int i = 0; i < 2; ++i) { int R, C; stage_rc(tid * 16 + i * 8192, R, C); const int Rb = Epi::PERM ? ((R & ~31) + perm32(R & 31)) : R;
        voffA[i] = (unsigned)(R * ld + C) * 2u; voffB[i] = (unsigned)(Rb * ld + C) * 2u; }
    const size_t kstep = (size_t)(BK * 2);
    const size_t hstep = (size_t)HALF * ld * 2;
    const size_t tstep = 2 * hstep;
    const unsigned ldsw = (unsigned)wid * 1024u;
    const int aoff = lds_byte(wr * 64 + fr, fq * 8), boff = lds_byte(wc * 32 + fr, fq * 8);
#define PG8_SA(b, h) (((b) * 2 + (h)) * HTB)
#define PG8_SB(b, h) ((4 + (b) * 2 + (h)) * HTB)
#define PG8_STAGE(bufoff, gbase, voff) do { _Pragma("unroll") for (int _i = 0; _i < 2; ++_i) \
        __builtin_amdgcn_global_load_lds((const unsigned*)((const char*)(gbase) + (voff)[_i]), (PG8_LAS unsigned*)(lds + (bufoff) + ldsw + _i * 8192), 16, 0, 0); } while (0)
#define PG8_LDA(dst, b, h) do { _Pragma("unroll") for (int m = 0; m < 4; ++m) _Pragma("unroll") for (int k = 0; k < 2; ++k) dst[m][k] = *(const PG8_LAS bf16x8*)(lds + PG8_SA(b, h) + aoff + m * 2048 + k * 1024); } while (0)
#define PG8_LDB(dst, b, h) do { _Pragma("unroll") for (int n = 0; n < 2; ++n) _Pragma("unroll") for (int k = 0; k < 2; ++k) dst[n][k] = *(const PG8_LAS bf16x8*)(lds + PG8_SB(b, h) + boff + n * 2048 + k * 1024); } while (0)
#define PG8_MMA(ai, bj, At, Bt) do { __builtin_amdgcn_s_setprio(1); _Pragma("unroll") for (int m = 0; m < 4; ++m) _Pragma("unroll") for (int n = 0; n < 2; ++n) _Pragma("unroll") for (int k = 0; k < 2; ++k) \
        acc[ai][bj][m][n] = __builtin_amdgcn_mfma_f32_16x16x32_bf16(Bt[n][k], At[m][k], acc[ai][bj][m][n], 0, 0, 0); __builtin_amdgcn_s_setprio(0); } while (0)
#define PG8_WAIT_V(n) asm volatile("s_waitcnt vmcnt(" #n ")" ::: "memory")
#define PG8_WAIT_L(n) asm volatile("s_waitcnt lgkmcnt(" #n ")" ::: "memory")
#define PG8_BAR __builtin_amdgcn_s_barrier()
#define PG8_SCHED __builtin_amdgcn_sched_barrier(0)
    Unit cur, nxt; int ui = 0;
    if (!S.next(0, cur)) return;
    f32x4 acc[2][2][4][2];
#pragma unroll
    for (int a = 0; a < 2; ++a)
#pragma unroll
        for (int b = 0; b < 2; ++b)
#pragma unroll
            for (int m = 0; m < 4; ++m)
#pragma unroll
                for (int n = 0; n < 2; ++n) acc[a][b][m][n] = (f32x4){0.f, 0.f, 0.f, 0.f};
    bf16x8 At[4][2], B0[2][2], B1[2][2];
    const size_t sstep = (size_t)K * 2;
    const char* cA = (const char*)g.A + (size_t)cur.pm * tstep + (size_t)cur.ks * sstep; const char* cB = (const char*)g.Bt + (size_t)cur.pn * tstep + (size_t)cur.ks * sstep;
    S.a_ready(cur);
    if constexpr (SP2) {
        PG8_STAGE(PG8_SB(0, 0), cB, voffB); PG8_STAGE(PG8_SB(0, 1), cB + hstep, voffB); PG8_STAGE(PG8_SA(0, 0), cA, voffA); PG8_STAGE(PG8_SA(0, 1), cA + hstep, voffA);
        if (wr == 1) PG8_BAR;
        PG8_WAIT_V(2); PG8_BAR;
        PG8_STAGE(PG8_SB(1, 0), cB + kstep, voffB); PG8_STAGE(PG8_SA(1, 0), cA + kstep, voffA); PG8_STAGE(PG8_SB(1, 1), cB + hstep + kstep, voffB);
        PG8_WAIT_V(6); PG8_BAR;
    } else {
        PG8_STAGE(PG8_SB(0, 0), cB, voffB); PG8_STAGE(PG8_SA(0, 0), cA, voffA); PG8_STAGE(PG8_SB(0, 1), cB + hstep, voffB); PG8_STAGE(PG8_SA(0, 1), cA + hstep, voffA);
        if (wr == 1) PG8_BAR;
        PG8_WAIT_V(4); PG8_BAR;
        PG8_STAGE(PG8_SB(1, 0), cB + kstep, voffB); PG8_STAGE(PG8_SA(1, 0), cA + kstep, voffA); PG8_STAGE(PG8_SB(1, 1), cB + hstep + kstep, voffB);
        PG8_WAIT_V(6); PG8_BAR;
    }
    for (;;) {
        const bool has_next = S.next(ui + 1, nxt);
        const char* nA = has_next ? (const char*)g.A + (size_t)nxt.pm * tstep + (size_t)nxt.ks * sstep : cA; const char* nB = has_next ? (const char*)g.Bt + (size_t)nxt.pn * tstep + (size_t)nxt.ks * sstep : cB;
        for (int t = 0; t < nt; t += 2) {
            const bool last = (t == nt - 2);
            const char* a1 = cA + (size_t)(t + 1) * kstep;
            const char* a2 = last ? nA : cA + (size_t)(t + 2) * kstep; const char* b2 = last ? nB : cB + (size_t)(t + 2) * kstep;
            const char* a3 = a2 + kstep; const char* b3 = b2 + kstep;
            if (last && has_next) S.a_ready(nxt);
            if constexpr (SP2) {
            PG8_LDB(B0, 0, 0); PG8_LDB(B1, 0, 1); PG8_SCHED; PG8_LDA(At, 0, 0); PG8_STAGE(PG8_SA(1, 1), a1 + hstep, voffA);
            PG8_WAIT_V(8); PG8_WAIT_L(0); PG8_BAR; PG8_MMA(0, 0, At, B0); PG8_MMA(0, 1, At, B1); PG8_BAR; PG8_SCHED;
            PG8_LDA(At, 0, 1); PG8_STAGE(PG8_SB(0, 0), b2, voffB); PG8_STAGE(PG8_SB(0, 1), b2 + hstep, voffB); PG8_STAGE(PG8_SA(0, 0), a2, voffA);
            PG8_WAIT_V(8); PG8_WAIT_L(0); PG8_BAR; PG8_MMA(1, 0, At, B0); PG8_MMA(1, 1, At, B1); PG8_BAR; PG8_SCHED;
            PG8_LDB(B0, 1, 0); PG8_LDB(B1, 1, 1); PG8_SCHED; PG8_LDA(At, 1, 0); PG8_STAGE(PG8_SA(0, 1), a2 + hstep, voffA);
            PG8_WAIT_V(8); PG8_WAIT_L(0); PG8_BAR; PG8_MMA(0, 0, At, B0); PG8_MMA(0, 1, At, B1); PG8_BAR; PG8_SCHED;
            PG8_LDA(At, 1, 1); PG8_STAGE(PG8_SB(1, 0), b3, voffB); PG8_STAGE(PG8_SB(1, 1), b3 + hstep, voffB); PG8_STAGE(PG8_SA(1, 0), a3, voffA);
            PG8_WAIT_V(8); PG8_WAIT_L(0); PG8_BAR; PG8_MMA(1, 0, At, B0); PG8_MMA(1, 1, At, B1); PG8_BAR; PG8_SCHED;
            } else {
            PG8_LDB(B0, 0, 0); PG8_SCHED; PG8_LDA(At, 0, 0); PG8_STAGE(PG8_SA(1, 1), a1 + hstep, voffA);
            PG8_WAIT_L(8); PG8_BAR; PG8_WAIT_L(0); PG8_MMA(0, 0, At, B0); PG8_BAR; PG8_SCHED;
            PG8_LDB(B1, 0, 1); PG8_STAGE(PG8_SB(0, 0), b2, voffB);
            PG8_BAR; PG8_WAIT_L(0); PG8_MMA(0, 1, At, B1); PG8_BAR;
            PG8_LDA(At, 0, 1); PG8_STAGE(PG8_SA(0, 0), a2, voffA);
            PG8_BAR; PG8_WAIT_L(0); PG8_MMA(1, 0, At, B0); PG8_BAR; PG8_SCHED;
            PG8_STAGE(PG8_SB(0, 1), b2 + hstep, voffB);
            PG8_WAIT_V(6); PG8_BAR; PG8_MMA(1, 1, At, B1); PG8_BAR;
            PG8_LDB(B0, 1, 0); PG8_SCHED; PG8_LDA(At, 1, 0); PG8_STAGE(PG8_SA(0, 1), a2 + hstep, voffA);
            PG8_WAIT_L(8); PG8_BAR; PG8_WAIT_L(0); PG8_MMA(0, 0, At, B0); PG8_BAR; PG8_SCHED;
            PG8_LDB(B1, 1, 1); PG8_STAGE(PG8_SB(1, 0), b3, voffB);
            PG8_BAR; PG8_WAIT_L(0); PG8_MMA(0, 1, At, B1); PG8_BAR;
            PG8_LDA(At, 1, 1); PG8_STAGE(PG8_SA(1, 0), a3, voffA);
            PG8_BAR; PG8_WAIT_L(0); PG8_MMA(1, 0, At, B0); PG8_BAR; PG8_SCHED;
            PG8_STAGE(PG8_SB(1, 1), b3 + hstep, voffB);
            PG8_WAIT_V(6); PG8_BAR; PG8_MMA(1, 1, At, B1); PG8_BAR;
            }
        }
        if constexpr (ALIGN_EPI) { if (wr == 0) PG8_BAR; }
        if constexpr (!Epi::AFTER_DRAIN) { E(acc, cur, wr, wc, fr, fq); S.done(cur); }
        if (!has_next) break;
#pragma unroll
        for (int a = 0; a < 2; ++a)
#pragma unroll
            for (int b = 0; b < 2; ++b)
#pragma unroll
                for (int m = 0; m < 4; ++m)
#pragma unroll
                    for (int n = 0; n < 2; ++n) acc[a][b][m][n] = (f32x4){0.f, 0.f, 0.f, 0.f};
        cur = nxt; cA = nA; cB = nB; ++ui;
        if constexpr (ALIGN_EPI) { if (wr == 1) PG8_BAR; }
    }
    PG8_WAIT_V(0);
    if constexpr (!ALIGN_EPI) { if (wr == 0) PG8_BAR; }
    PG8_BAR;
    if constexpr (Epi::AFTER_DRAIN) { E.fused(acc, cur, wr, wc, fr, fq, lds, wid, lane); S.done(cur); }
#undef PG8_SA
#undef PG8_SB
#undef PG8_STAGE
#undef PG8_LDA
#undef PG8_LDB
#undef PG8_MMA
#undef PG8_WAIT_V
#undef PG8_WAIT_L
#undef PG8_BAR
#undef PG8_SCHED
}
}

#ifndef MK_N_LAUNCHES
#define MK_N_LAUNCHES 1
#endif

#define LAS __attribute__((address_space(3)))
typedef unsigned short bf16_t;
typedef unsigned u32x4 __attribute__((ext_vector_type(4)));
typedef unsigned u32x2 __attribute__((ext_vector_type(2)));
typedef float f32x4 __attribute__((ext_vector_type(4)));
typedef float f32x2 __attribute__((ext_vector_type(2)));
typedef short bf16x8 __attribute__((ext_vector_type(8)));

constexpr int D = 1024, NBATCH = 8, SEQL = 2048, CTXL = 256;
constexpr int RL = NBATCH * SEQL;
constexpr int RC = NBATCH * CTXL;
constexpr int RT = RL + RC;
constexpr int PIN = 2848, PINP = 3072, PALD = 1536, PRLD = 1280, FF = 4096;
constexpr float EPS = 1e-6f;
constexpr int NTHREADS = 512, NWAVES = 8;
constexpr int LDS_BYTES = 163840;
constexpr int LDS_BARST = LDS_BYTES - 16;
constexpr int NPHASES = 22;

constexpr size_t MiB = 1u << 20;
constexpr size_t WS_WT = 0;
constexpr size_t WT_LAYER = 24 * MiB, WT_OUT = 6 * MiB, WT_W1 = 8 * MiB, WT_W2 = 16 * MiB;
constexpr size_t WS_XN = 48 * MiB;
constexpr size_t WS_PA = 84 * MiB;
constexpr size_t WS_PR = 138 * MiB;
constexpr size_t WS_CV = 183 * MiB;
constexpr size_t WS_RAWB = 84 * MiB;
constexpr size_t WS_H = 84 * MiB;
constexpr size_t WS_CTXRES = 237 * MiB;
constexpr size_t WS_GATES = 245 * MiB;
constexpr size_t WS_MOD = 248 * MiB;
constexpr size_t WS_CTL = 249 * MiB;
constexpr size_t CTL_BYTES = 16384;
constexpr size_t WS_PART = WS_H;
constexpr size_t WS_END = 250 * MiB;

struct Params { const float* in[31]; float* out; unsigned char* ws; int lo, hi; };

enum { I_X = 0, I_C, I_CTX, I_CCTX, I_WADA, I_BADA, I_GMIX, I_WIN, I_CAW, I_CAB, I_BIG, I_BFG, I_GHA, I_CBW, I_CBB, I_DTB, I_ALOG, I_DSKIP, I_GNB,
       I_CCW, I_CCB, I_WRG, I_BRG, I_LAM, I_WOUT, I_GMLP, I_W1, I_B1, I_W2, I_B2, I_GFIN };

__device__ __forceinline__ unsigned f2bf(float f) { unsigned u = __builtin_bit_cast(unsigned, f); return (u + 0x7fffu + ((u >> 16) & 1u)) >> 16; }
typedef __bf16 bf16x2_t __attribute__((ext_vector_type(2)));
__device__ __forceinline__ unsigned pk2(float lo, float hi) { const f32x2 v = {lo, hi}; const bf16x2_t b = __builtin_convertvector(v, bf16x2_t); return __builtin_bit_cast(unsigned, b); }
__device__ __forceinline__ float bf_lo(unsigned u) { return __builtin_bit_cast(float, u << 16); }
__device__ __forceinline__ float bf_hi(unsigned u) { return __builtin_bit_cast(float, u & 0xffff0000u); }
__device__ __forceinline__ float bf1(unsigned short h) { return __builtin_bit_cast(float, ((unsigned)h) << 16); }
__device__ __forceinline__ float wave_sum(float v) {
#pragma unroll
    for (int o = 1; o < 64; o <<= 1) v += __shfl_xor(v, o);
    return v;
}
__device__ __forceinline__ float sigmoidf_(float x) { return __builtin_amdgcn_rcpf(1.f + __expf(-x)); }
__device__ __forceinline__ float siluf_(float x) { return x * __builtin_amdgcn_rcpf(1.f + __expf(-x)); }
__device__ __forceinline__ float softplusf_(float x) { return fmaxf(x, 0.f) + log1pf(__expf(-fabsf(x))); }
__device__ __forceinline__ float gelu_tanh(float x) { const float u = 0.7978845608028654f * (x + 0.044715f * x * x * x); const float e = __expf(2.f * u); const float th = 1.f - 2.f / (e + 1.f); return 0.5f * x * (1.f + th); }

__device__ __forceinline__ void st16_wt(void* ptr, u32x4 v) { asm volatile("global_store_dwordx4 %0, %1, off sc1\n\ts_nop 1" :: "v"(ptr), "v"(v) : "memory"); }
__device__ __forceinline__ void st16_wt(void* ptr, f32x4 v) { asm volatile("global_store_dwordx4 %0, %1, off sc1\n\ts_nop 1" :: "v"(ptr), "v"(v) : "memory"); }
__device__ __forceinline__ void st8_wt(void* ptr, u32x2 v) { __hip_atomic_store((unsigned long long*)ptr, __builtin_bit_cast(unsigned long long, v), __ATOMIC_RELAXED, __HIP_MEMORY_SCOPE_AGENT); }
__device__ __forceinline__ void st4_wt(float* ptr, float v) { __hip_atomic_store(ptr, v, __ATOMIC_RELAXED, __HIP_MEMORY_SCOPE_AGENT); }
#define LDS_BARRIER() asm volatile("s_waitcnt lgkmcnt(0)\n\ts_barrier" ::: "memory")
constexpr int LS = 72;
__device__ __forceinline__ f32x4 mma64(const LAS bf16_t* A, const LAS bf16_t* Bt, int lane, f32x4 acc) {
    const int r = lane & 15, q = lane >> 4;
#pragma unroll
    for (int kk = 0; kk < 2; ++kk) {
        const bf16x8 a = *(const LAS bf16x8*)(A + r * LS + kk * 32 + q * 8);
        const bf16x8 b = *(const LAS bf16x8*)(Bt + r * LS + kk * 32 + q * 8);
        acc = __builtin_amdgcn_mfma_f32_16x16x32_bf16(a, b, acc, 0, 0, 0);
    }
    return acc;
}

typedef short v4i16_t __attribute__((ext_vector_type(4)));
__device__ __forceinline__ bf16x8 tr_frag(const LAS bf16_t* T, int ld, int ctile, int kk, int lane) {
    const int g = lane >> 4, q = (lane & 15) >> 2, pp = lane & 3;
    const LAS bf16_t* a0 = T + (32 * kk + 8 * g + q) * ld + 16 * ctile + 4 * pp;
    const v4i16_t lo = __builtin_amdgcn_ds_read_tr16_b64_v4i16((LAS v4i16_t*)a0), hi = __builtin_amdgcn_ds_read_tr16_b64_v4i16((LAS v4i16_t*)(a0 + 4 * ld));
    return (bf16x8){lo.x, lo.y, lo.z, lo.w, hi.x, hi.y, hi.z, hi.w};
}
#define XB_TMO      128
#define XB_XCNT(j)  (256  + 64 * (j))
#define XB_XSUB(j)  (1280 + 64 * (j))
#define XB_XGEN(j)  (2304 + 64 * (j))
#define XB_TOP      3328
#define XB_TOPGEN   3392
#define XCD_BAR_WORDS 3456
#define XB_SPIN_CAP (1u << 18)

__device__ __forceinline__ unsigned xb_ld(unsigned* p)              { return __hip_atomic_load(p, __ATOMIC_RELAXED, __HIP_MEMORY_SCOPE_AGENT); }
__device__ __forceinline__ unsigned xb_add(unsigned* p, unsigned v) { return __hip_atomic_fetch_add(p, v, __ATOMIC_RELAXED, __HIP_MEMORY_SCOPE_AGENT); }
__device__ __forceinline__ unsigned xb_xcc_id() { return (unsigned)__builtin_amdgcn_s_getreg((3 << 11) | 20) & 0xFu; }
#define XB_SPIN(cond, bar) do { unsigned _sp = 0; while (cond) { __builtin_amdgcn_s_sleep(1); \
    if ((++_sp & 255u) == 0u) { if (xb_ld(&(bar)[XB_TMO])) break; if (_sp > XB_SPIN_CAP) { atomicAdd(&(bar)[XB_TMO], 1u); break; } } } } while (0)

struct XcdBarrier {
    unsigned* bar; unsigned x;
    volatile LAS unsigned* st;
};

__device__ __forceinline__ XcdBarrier xcd_barrier_post(unsigned* bar, volatile LAS unsigned* st) {
    XcdBarrier b; b.bar = bar; b.x = xb_xcc_id(); b.st = st;
    if (threadIdx.x == 0) (void)xb_add(&bar[XB_XCNT(b.x)], 1u);
    return b;
}
__device__ __forceinline__ void xcd_barrier_complete(unsigned* bar, unsigned x, unsigned& nloc, unsigned& nx) {
    const unsigned G = gridDim.x * gridDim.y * gridDim.z;
    unsigned sum, cnt, mine, sp = 0u;
    for (;;) {
        sum = 0u; cnt = 0u; mine = 0u;
#pragma unroll
        for (unsigned j = 0; j < 16; ++j) { const unsigned c = xb_ld(&bar[XB_XCNT(j)]); sum += c; cnt += (c > 0u) ? 1u : 0u; mine = (j == x) ? c : mine; }
        if (sum == G) break;
        __builtin_amdgcn_s_sleep(1);
        if ((++sp & 255u) == 0u) { if (xb_ld(&bar[XB_TMO])) break; if (sp > XB_SPIN_CAP) { atomicAdd(&bar[XB_TMO], 1u); break; } }
    }
    nloc = mine > 0u ? mine : 1u; nx = cnt > 0u ? cnt : 1u;
}

__device__ __forceinline__ void xcd_barrier(const XcdBarrier& b) {
    asm volatile("s_waitcnt vmcnt(0)" ::: "memory");
    __syncthreads();
    if (threadIdx.x == 0) {
        unsigned* bar = b.bar;
        __builtin_amdgcn_s_waitcnt(0);
        unsigned nloc = b.st[0], nx = b.st[1];
        if (nloc == 0u) { xcd_barrier_complete(bar, b.x, nloc, nx); b.st[0] = nloc; b.st[1] = nx; }
        const unsigned old = xb_add(&bar[XB_XSUB(b.x)], 1u);
        const unsigned gen = old / nloc;
        if (old + 1u == (gen + 1u) * nloc) {
            __builtin_amdgcn_fence(__ATOMIC_RELEASE, "agent");
            asm volatile("s_waitcnt vmcnt(0)" ::: "memory");
            const unsigned og = xb_add(&bar[XB_TOP], 1u);
            const unsigned tg = og / nx;
            if (og + 1u == (tg + 1u) * nx) xb_add(&bar[XB_TOPGEN], 1u);
            else XB_SPIN(xb_ld(&bar[XB_TOPGEN]) == tg, bar);
            __builtin_amdgcn_fence(__ATOMIC_ACQUIRE, "agent");
            xb_add(&bar[XB_XGEN(b.x)], 1u);
            asm volatile("s_waitcnt vmcnt(0)" ::: "memory");
        } else {
            XB_SPIN(xb_ld(&bar[XB_XGEN(b.x)]) == gen, bar);
            __builtin_amdgcn_fence(__ATOMIC_ACQUIRE, "agent");
            asm volatile("s_waitcnt vmcnt(0)" ::: "memory");
        }
    }
    __syncthreads();
}

struct EpiAll {
    static constexpr bool PERM = true, AFTER_DRAIN = false;
    const Params* pp; int kind, l;
    __device__ __forceinline__ void operator()(const pg8::f32x4 (&acc)[2][2][4][2], const pg8::Unit& u, int wr, int wc, int fr, int fq) const {
        const Params& p = *pp;
        if (kind == 0) {
            const int row0 = u.pm * 256 + wr * 64 + fr;
            if (u.pn < 11) {
                const bool pa = u.pn < 6; const int ld = pa ? PALD : PRLD;
                bf16_t* P = (bf16_t*)(p.ws + (pa ? WS_PA : WS_PR));
                const int col0 = (pa ? u.pn : u.pn - 6) * 256 + wc * 32 + 8 * fq;
#pragma unroll
                for (int ai = 0; ai < 2; ++ai)
#pragma unroll
                    for (int m = 0; m < 4; ++m) { bf16_t* rowp = P + (size_t)(row0 + ai * 128 + m * 16) * ld + col0;
#pragma unroll
                        for (int bj = 0; bj < 2; ++bj) { const pg8::f32x4 v0 = acc[ai][bj][m][0], v1 = acc[ai][bj][m][1];
                            u32x4 w; w.x = pg8::cvt_pk_bf16(v0[0], v0[1]); w.y = pg8::cvt_pk_bf16(v0[2], v0[3]); w.z = pg8::cvt_pk_bf16(v1[0], v1[1]); w.w = pg8::cvt_pk_bf16(v1[2], v1[3]);
                            st16_wt(rowp + bj * 128, w); } }
            } else if (wc == 0) {
                float* gates = (float*)(p.ws + WS_GATES);
#pragma unroll
                for (int ai = 0; ai < 2; ++ai)
#pragma unroll
                    for (int m = 0; m < 4; ++m) { float* gp = gates + (size_t)(row0 + ai * 128 + m * 16) * 32 + 8 * fq;
                        st16_wt(gp, acc[ai][0][m][0]); st16_wt(gp + 4, acc[ai][0][m][1]); }
            }
        } else if (kind == 4) {
            bf16_t* part = (bf16_t*)(p.ws + WS_PART) + (size_t)u.ks * RC * D;
            const int row0 = u.pm * 256 + wr * 64 + fr; const int col0 = u.pn * 256 + wc * 32 + 8 * fq;
#pragma unroll
            for (int bj = 0; bj < 2; ++bj)
#pragma unroll
                for (int ai = 0; ai < 2; ++ai)
#pragma unroll
                    for (int m = 0; m < 4; ++m) { const pg8::f32x4 v0 = acc[ai][bj][m][0], v1 = acc[ai][bj][m][1];
                        u32x4 w; w.x = pk2(v0[0], v0[1]); w.y = pk2(v0[2], v0[3]); w.z = pk2(v1[0], v1[1]); w.w = pk2(v1[2], v1[3]);
                        st16_wt(part + (size_t)(row0 + ai * 128 + m * 16) * D + col0 + bj * 128, w); }
        } else if (kind == 2) {
            bf16_t* H = (bf16_t*)(p.ws + WS_H); const float* b1 = p.in[I_B1] + l * FF;
            const int row0 = u.pm * 256 + wr * 64 + fr; const int col0 = u.pn * 256 + wc * 32 + 8 * fq;
#pragma unroll
            for (int bj = 0; bj < 2; ++bj) { const int c = col0 + bj * 128;
                const f32x4 b0 = *(const f32x4*)(b1 + c), bb1 = *(const f32x4*)(b1 + c + 4);
#pragma unroll
                for (int ai = 0; ai < 2; ++ai)
#pragma unroll
                    for (int m = 0; m < 4; ++m) { f32x4 v0 = acc[ai][bj][m][0] + b0, v1 = acc[ai][bj][m][1] + bb1;
#pragma unroll
                        for (int i = 0; i < 4; ++i) { const float a = fmaxf(v0[i], 0.f), b = fmaxf(v1[i], 0.f); v0[i] = a * a; v1[i] = b * b; }
                        u32x4 w; w.x = pg8::cvt_pk_bf16(v0[0], v0[1]); w.y = pg8::cvt_pk_bf16(v0[2], v0[3]); w.z = pg8::cvt_pk_bf16(v1[0], v1[1]); w.w = pg8::cvt_pk_bf16(v1[2], v1[3]);
                        st16_wt(H + (size_t)(row0 + ai * 128 + m * 16) * FF + c, w); } }
        } else {
            const bool lat = u.pm < 64; const int bsel = lat ? (u.pm >> 3) : 8;
            const float* gate = (const float*)(p.ws + WS_MOD) + (size_t)(l * 9 + bsel) * 6144 + (kind == 1 ? 2 : 5) * 1024;
            const float* bias = p.in[I_B2] + l * D;
            const float bsc = kind == 3 ? 1.f : 0.f;
            const int rloc = (lat ? u.pm : u.pm - 64) * 256 + wr * 64 + fr;
            bf16_t* rs = lat ? (bf16_t*)p.out : (bf16_t*)(p.ws + WS_CTXRES);
            const bool f32src = (kind == 1 && l == 0);
            const float* ipf = (lat ? p.in[I_X] : p.in[I_CTX]) + (size_t)rloc * D;
            const bf16_t* ipb = rs + (size_t)rloc * D;
            bf16_t* op = ((kind == 3 && l == 1) ? (bf16_t*)(p.ws + WS_XN) : rs) + (size_t)rloc * D;
            const int col0 = u.pn * 256 + wc * 32 + 8 * fq;
#pragma unroll
            for (int bj = 0; bj < 2; ++bj) { const int c = col0 + bj * 128;
                const f32x4 g0 = *(const f32x4*)(gate + c), g1 = *(const f32x4*)(gate + c + 4);
                const f32x4 b0 = *(const f32x4*)(bias + c) * bsc, b1 = *(const f32x4*)(bias + c + 4) * bsc;
#pragma unroll
                for (int ai = 0; ai < 2; ++ai)
#pragma unroll
                    for (int m = 0; m < 4; ++m) { const size_t ro = (size_t)(ai * 128 + m * 16) * D + c;
                        f32x4 x0, x1;
                        if (f32src) { x0 = *(const f32x4*)(ipf + ro); x1 = *(const f32x4*)(ipf + ro + 4); }
                        else { const u32x4 xb = *(const u32x4*)(ipb + ro); x0 = (f32x4){bf_lo(xb.x), bf_hi(xb.x), bf_lo(xb.y), bf_hi(xb.y)}; x1 = (f32x4){bf_lo(xb.z), bf_hi(xb.z), bf_lo(xb.w), bf_hi(xb.w)}; }
                        const f32x4 y0 = x0 + g0 * (acc[ai][bj][m][0] + b0), y1 = x1 + g1 * (acc[ai][bj][m][1] + b1);
                        u32x4 w; w.x = pk2(y0[0], y0[1]); w.y = pk2(y0[2], y0[3]); w.z = pk2(y1[0], y1[1]); w.w = pk2(y1[2], y1[3]);
                        st16_wt(op + ro, w); } }
        }
    }
};

struct Order {
    pg8::StaticOrder so; int nslice;
    __device__ __forceinline__ bool next(int i, pg8::Unit& u) const {
        if (nslice == 0) return so.next(i, u);
        const int Lx = i * so.G + so.c; if (Lx >= nslice * 32) return false;
        u.ks = Lx >> 5; const int t = Lx & 31; u.pm = t >> 2; u.pn = t & 3; return true;
    }
    __device__ __forceinline__ void a_ready(const pg8::Unit&) const {}
    __device__ __forceinline__ void done(const pg8::Unit&) const {}
};
__device__ __forceinline__ int inproj_dest(int n) {
    if (n < 512) return n;
    if (n < 1024) return 1536 + (n - 512);
    if (n < 1040) return 2816 + (n - 1024);
    if (n < 1552) return 2048 + (n - 1040);
    if (n < 2064) return 512 + (n - 1552);
    if (n < 2320) return 1024 + (n - 2064);
    if (n < 2336) return 2832 + (n - 2320);
    if (n < 2592) return 1280 + (n - 2336);
    return 2560 + (n - 2592);
}
template <bool INMAP>
__device__ __forceinline__ void transpose_item(const float* W, int K, int N, bf16_t* WT, LAS float* scr, int item, int lane) {
    const int nblk = N / 32, kb = item / nblk, nb = item % nblk, k0 = 64 * kb, n0 = 32 * nb;
#pragma unroll 8
    for (int i = 0; i < 32; ++i) { const int kk = 2 * i + (lane >> 5); scr[kk * 33 + (lane & 31)] = W[(size_t)(k0 + kk) * N + n0 + (lane & 31)]; }
    asm volatile("s_waitcnt lgkmcnt(0)" ::: "memory");
    const int c = lane & 7;
#pragma unroll
    for (int j = 0; j < 4; ++j) { const int n = (lane >> 3) + 8 * j; const LAS float* s = scr + (8 * c) * 33 + n;
        u32x4 o; o.x = pk2(s[0 * 33], s[1 * 33]); o.y = pk2(s[2 * 33], s[3 * 33]); o.z = pk2(s[4 * 33], s[5 * 33]); o.w = pk2(s[6 * 33], s[7 * 33]);
        const int row = INMAP ? inproj_dest(n0 + n) : (n0 + n);
        st16_wt(WT + (size_t)row * K + k0 + 8 * c, o); }
    asm volatile("s_waitcnt lgkmcnt(0)" ::: "memory");
}
__device__ __forceinline__ void phase0(const Params& p, LAS unsigned char* L) {
    const int tid = tid_opaque(), lane = tid & 63, wave = tid >> 6;
    LAS float* sS = (LAS float*)L;
    LAS float* red = (LAS float*)(L + 36864);
    for (int i = tid; i < 9 * 1024; i += NTHREADS) { const int v = i >> 10, k = i & 1023; const float x = v < 8 ? p.in[I_C][v * 1024 + k] : p.in[I_CCTX][k]; sS[i] = siluf_(x); }
    __syncthreads();
    float* mod = (float*)(p.ws + WS_MOD);
    for (int unit = blockIdx.x; unit < 192; unit += gridDim.x) {
        const int l = unit / 96, nb = (unit % 96) * 64;
        const float* W = p.in[I_WADA] + (size_t)l * 1024 * 6144 + nb + lane;
        float acc[9];
#pragma unroll
        for (int v = 0; v < 9; ++v) acc[v] = 0.f;
#pragma unroll 8
        for (int k = wave * 128; k < wave * 128 + 128; k += 4) {
            const float w0 = W[(size_t)k * 6144], w1 = W[(size_t)(k + 1) * 6144], w2 = W[(size_t)(k + 2) * 6144], w3 = W[(size_t)(k + 3) * 6144];
#pragma unroll
            for (int v = 0; v < 9; ++v) { const f32x4 s4 = *(const LAS f32x4*)(sS + v * 1024 + k); acc[v] += (s4.x * w0 + s4.y * w1) + (s4.z * w2 + s4.w * w3); } }
#pragma unroll
        for (int v = 0; v < 9; ++v) red[(wave * 9 + v) * 64 + lane] = acc[v];
        __syncthreads();
        for (int i = tid; i < 576; i += NTHREADS) { const int v = i >> 6, ln = i & 63; float s = 0.f;
#pragma unroll
            for (int w = 0; w < 8; ++w) s += red[(w * 9 + v) * 64 + ln];
            st4_wt(mod + (size_t)(l * 9 + v) * 6144 + nb + ln, s + p.in[I_BADA][l * 6144 + nb + ln]); }
        __syncthreads();
    }
    __syncthreads();
    LAS float* scr = (LAS float*)(L + wave * 16384);
    const int gw = blockIdx.x * NWAVES + wave, NGW = gridDim.x * NWAVES;
    constexpr int I_IN = 16 * 89, I_OUT = 16 * 32, I_M1 = 16 * 128, I_M2 = 64 * 32, I_LAYER = I_IN + I_OUT + I_M1 + I_M2;
    const bool bal = (gridDim.x == 256); const int bx = blockIdx.x;
    const int nmine = !bal ? (2 * I_LAYER + NGW - 1) / NGW : (bx >= 192 ? 11 : (bx < 36 ? 5 : 4));
    for (int j = 0; j < nmine; ++j) {
        int it;
        if (!bal) it = gw + j * NGW;
        else if (bx >= 192) it = (bx - 192) * 88 + wave * 11 + j;
        else it = j < 4 ? 5632 + bx * 32 + wave * 4 + j : 11776 + bx * 8 + wave;
        if (it >= 2 * I_LAYER) continue;
        const int l = it / I_LAYER; int r = it % I_LAYER;
        bf16_t* wt = (bf16_t*)(p.ws + WS_WT + (size_t)l * WT_LAYER);
        if (r < I_IN) { transpose_item<true>(p.in[I_WIN] + (size_t)l * 1024 * PIN, 1024, PIN, wt, scr, r, lane); continue; } r -= I_IN;
        if (r < I_OUT) { transpose_item<false>(p.in[I_WOUT] + (size_t)l * 1024 * 1024, 1024, 1024, (bf16_t*)((unsigned char*)wt + WT_OUT), scr, r, lane); continue; } r -= I_OUT;
        if (r < I_M1) { transpose_item<false>(p.in[I_W1] + (size_t)l * 1024 * FF, 1024, FF, (bf16_t*)((unsigned char*)wt + WT_W1), scr, r, lane); continue; } r -= I_M1;
        transpose_item<false>(p.in[I_W2] + (size_t)l * FF * 1024, FF, 1024, (bf16_t*)((unsigned char*)wt + WT_W2), scr, r, lane);
    }
}

__device__ __forceinline__ void normmod_phase(const Params& p, int l, int which) {
    const bool first = (which == 0 && l == 0);
    const float* xlat = p.in[I_X]; const float* xctx = p.in[I_CTX];
    const bf16_t* rlat = (const bf16_t*)p.out; const bf16_t* rctx = (const bf16_t*)(p.ws + WS_CTXRES);
    const int nrows = (l == 1 && which == 1) ? RL : RT;
    const float* g = (which == 0 ? p.in[I_GMIX] : p.in[I_GMLP]) + l * D; const float* modl = (const float*)(p.ws + WS_MOD) + (size_t)l * 9 * 6144;
    const int shi = which == 0 ? 0 : 3, sci = shi + 1;
    const int tid = tid_opaque(), lane = tid & 63, wave = tid >> 6;
    const int gw = blockIdx.x * NWAVES + wave, NGW = gridDim.x * NWAVES;
    bf16_t* XN = (bf16_t*)(p.ws + WS_XN);
    for (int row = gw; row < nrows; row += NGW) {
        const bool lat = row < RL; const int bsel = lat ? (row >> 11) : 8;
        const float* xr = lat ? xlat + (size_t)row * D : xctx + (size_t)(row - RL) * D;
        const bf16_t* xb = lat ? rlat + (size_t)row * D : rctx + (size_t)(row - RL) * D;
        const float* sh = modl + bsel * 6144 + shi * 1024; const float* sc = modl + bsel * 6144 + sci * 1024;
        f32x4 v[4]; float s = 0.f;
        const bool fold = (which == 0 && l == 1 && !lat);
#pragma unroll
        for (int j = 0; j < 4; ++j) { const int cj = 8 * lane + 512 * (j >> 1) + 4 * (j & 1);
            if (first) v[j] = *(const f32x4*)(xr + cj); else { const u32x2 t = *(const u32x2*)(xb + cj); v[j] = (f32x4){bf_lo(t.x), bf_hi(t.x), bf_lo(t.y), bf_hi(t.y)}; }
            if (fold) { const bf16_t* pt = (const bf16_t*)(p.ws + WS_PART) + (size_t)(row - RL) * D + cj;
                f32x4 a = *(const f32x4*)(p.in[I_B2] + cj);
#pragma unroll
                for (int ks = 0; ks < 4; ++ks) { const u32x2 t = *(const u32x2*)(pt + (size_t)ks * RC * D); a = a + (f32x4){bf_lo(t.x), bf_hi(t.x), bf_lo(t.y), bf_hi(t.y)}; }
                v[j] = v[j] + *(const f32x4*)((const float*)(p.ws + WS_MOD) + 8 * 6144 + 5 * 1024 + cj) * a; } s += (v[j].x * v[j].x + v[j].y * v[j].y) + (v[j].z * v[j].z + v[j].w * v[j].w); }
        const float rs = rsqrtf(wave_sum(s) * (1.f / D) + EPS);
#pragma unroll
        for (int h = 0; h < 2; ++h) { const int c = 8 * lane + 512 * h;
            const f32x4 g0 = *(const f32x4*)(g + c), g1 = *(const f32x4*)(g + c + 4), s0 = *(const f32x4*)(sh + c), s1 = *(const f32x4*)(sh + c + 4), c0 = *(const f32x4*)(sc + c), c1 = *(const f32x4*)(sc + c + 4);
            const f32x4 o0 = v[2 * h] * rs * g0 * (c0 + 1.f) + s0, o1 = v[2 * h + 1] * rs * g1 * (c1 + 1.f) + s1;
            u32x4 w; w.x = pk2(o0.x, o0.y); w.y = pk2(o0.z, o0.w); w.z = pk2(o1.x, o1.y); w.w = pk2(o1.z, o1.w);
            st16_wt(XN + (size_t)row * D + c, w); }
    }
}
__device__ __forceinline__ void final_phase(const Params& p) {
    const int tid = tid_opaque(), lane = tid & 63, wave = tid >> 6;
    const int gw = blockIdx.x * NWAVES + wave, NGW = gridDim.x * NWAVES;
    const float* g = p.in[I_GFIN]; const bf16_t* X = (const bf16_t*)(p.ws + WS_XN);
    for (int row = gw; row < RL; row += NGW) {
        const bf16_t* xb = X + (size_t)row * D; float* xr = p.out + (size_t)row * D;
        f32x4 v[4]; float s = 0.f;
#pragma unroll
        for (int j = 0; j < 4; ++j) { const u32x2 t = *(const u32x2*)(xb + 4 * lane + 256 * j); v[j] = (f32x4){bf_lo(t.x), bf_hi(t.x), bf_lo(t.y), bf_hi(t.y)}; s += (v[j].x * v[j].x + v[j].y * v[j].y) + (v[j].z * v[j].z + v[j].w * v[j].w); }
        const float rs = rsqrtf(wave_sum(s) * (1.f / D) + EPS);
#pragma unroll
        for (int j = 0; j < 4; ++j) { const int c = 4 * lane + 256 * j; const f32x4 gg = *(const f32x4*)(g + c); *(f32x4*)(xr + c) = v[j] * rs * gg; }
    }
}
__device__ __forceinline__ void finalize_phase(const Params& p, int l, int nrows) {
    const int tid = tid_opaque(), lane = tid & 63, wave = tid >> 6;
    const int gw = blockIdx.x * NWAVES + wave, NGW = gridDim.x * NWAVES;
    bf16_t* RF = (bf16_t*)(p.ws + WS_XN); const bf16_t* RB = (const bf16_t*)(p.ws + WS_RAWB); const bf16_t* P = (const bf16_t*)(p.ws + WS_PR);
    const float* gha = p.in[I_GHA] + l * 256; const float* gnb = p.in[I_GNB] + l * 512;
    for (int row = gw; row < nrows; row += NGW) {
        bf16_t* rf = RF + (size_t)row * D + 4 * lane; const bf16_t* rb = RB + (size_t)row * D + 4 * lane; const bf16_t* pr = P + (size_t)row * PRLD + 4 * lane;
        float v[4][4];
#pragma unroll
        for (int sgi = 0; sgi < 4; ++sgi) { const u32x2 a = *(const u32x2*)(rf + sgi * 256), b = *(const u32x2*)(rb + sgi * 256);
            v[sgi][0] = bf_lo(a.x) + bf_lo(b.x); v[sgi][1] = bf_hi(a.x) + bf_hi(b.x); v[sgi][2] = bf_lo(a.y) + bf_lo(b.y); v[sgi][3] = bf_hi(a.y) + bf_hi(b.y); }
        const u32x2 ov = *(const u32x2*)(pr + 256), z0 = *(const u32x2*)(pr + 512), z1 = *(const u32x2*)(pr + 768), gv = *(const u32x2*)(pr + 1024);
        { float s = v[0][0] * v[0][0] + v[0][1] * v[0][1] + v[0][2] * v[0][2] + v[0][3] * v[0][3];
#pragma unroll
          for (int o = 1; o < 16; o <<= 1) s += __shfl_xor(s, o);
          const float rs = rsqrtf(s * (1.f / 64.f) + EPS); const f32x4 gg = *(const f32x4*)(gha + 4 * lane);
          v[0][0] = v[0][0] * rs * gg.x * sigmoidf_(bf_lo(ov.x)); v[0][1] = v[0][1] * rs * gg.y * sigmoidf_(bf_hi(ov.x));
          v[0][2] = v[0][2] * rs * gg.z * sigmoidf_(bf_lo(ov.y)); v[0][3] = v[0][3] * rs * gg.w * sigmoidf_(bf_hi(ov.y)); }
        { v[1][0] *= siluf_(bf_lo(z0.x)); v[1][1] *= siluf_(bf_hi(z0.x)); v[1][2] *= siluf_(bf_lo(z0.y)); v[1][3] *= siluf_(bf_hi(z0.y));
          v[2][0] *= siluf_(bf_lo(z1.x)); v[2][1] *= siluf_(bf_hi(z1.x)); v[2][2] *= siluf_(bf_lo(z1.y)); v[2][3] *= siluf_(bf_hi(z1.y));
          float s = 0.f;
#pragma unroll
          for (int i = 0; i < 4; ++i) s += v[1][i] * v[1][i] + v[2][i] * v[2][i];
          const float rs = rsqrtf(wave_sum(s) * (1.f / 512.f) + EPS);
          const f32x4 g0 = *(const f32x4*)(gnb + 4 * lane), g1 = *(const f32x4*)(gnb + 256 + 4 * lane);
#pragma unroll
          for (int i = 0; i < 4; ++i) { v[1][i] = v[1][i] * rs * g0[i]; v[2][i] = v[2][i] * rs * g1[i]; } }
        { v[3][0] *= gelu_tanh(bf_lo(gv.x)); v[3][1] *= gelu_tanh(bf_hi(gv.x)); v[3][2] *= gelu_tanh(bf_lo(gv.y)); v[3][3] *= gelu_tanh(bf_hi(gv.y)); }
#pragma unroll
        for (int sgi = 0; sgi < 4; ++sgi) { u32x2 w; w.x = pk2(v[sgi][0], v[sgi][1]); w.y = pk2(v[sgi][2], v[sgi][3]); st8_wt(rf + sgi * 256, w); }
    }
}

__device__ __forceinline__ void conv_phase(const Params& p, LAS unsigned char* L, int l) {
    const int tid = tid_opaque();
    if (tid >= 384) return;
    const int stream = tid >= 192 ? 1 : 0, cgp = tid - 192 * stream, c0 = cgp * 8;
    float w[5][8];
#pragma unroll
    for (int j = 0; j < 5; ++j)
#pragma unroll
        for (int i = 0; i < 8; ++i) { const int c = c0 + i; float v;
            if (c0 < 512) v = j < 4 ? p.in[I_CAW][(l * 4 + j) * 512 + c] : p.in[I_CAB][l * 512 + c];
            else if (c0 < 1280) v = j < 4 ? p.in[I_CBW][(l * 4 + j) * 768 + (c - 512)] : p.in[I_CBB][l * 768 + (c - 512)];
            else v = j < 4 ? p.in[I_CCW][(l * 4 + j) * 256 + (c - 1280)] : p.in[I_CCB][l * 256 + (c - 1280)];
            w[j][i] = v; }
    const bf16_t* PA = (const bf16_t*)(p.ws + WS_PA); bf16_t* CV = (bf16_t*)(p.ws + WS_CV);
    const bool act = c0 < 1280; const float qs = c0 < 256 ? 0.125f : 1.f;
    for (int it = blockIdx.x; it < 2304; it += gridDim.x) {
        const int seg = 2 * it + stream;
        const bool lat = seg < 4096; const int sb = lat ? seg : seg - 4096;
        const int bb = lat ? (sb >> 9) : (sb >> 6), pf0 = (lat ? (sb & 511) : (sb & 63)) * 4;
        const int Lseg = lat ? SEQL : CTXL, base = lat ? bb * SEQL : RL + bb * CTXL;
        const bool cm = lat && !act;
        u32x4 x[7];
#pragma unroll
        for (int r = 0; r < 7; ++r) { const int pj = pf0 + r - 2; const bool ok = (pj >= 0) && (pj < Lseg); const int pq = ok ? pj : pf0;
            const int tj = cm ? ((pq & 31) * 64 + (pq >> 5)) : pq;
            x[r] = *(const u32x4*)(PA + (size_t)(base + tj) * PALD + c0); if (!ok) x[r] = (u32x4){0u, 0u, 0u, 0u}; }
#pragma unroll
        for (int o = 0; o < 4; ++o) {
            float v[8];
#pragma unroll
            for (int i = 0; i < 8; ++i) v[i] = w[4][i];
#pragma unroll
            for (int j = 0; j < 4; ++j) { const u32x4 x_ = x[o + j];
                v[0] += w[j][0] * bf_lo(x_.x); v[1] += w[j][1] * bf_hi(x_.x); v[2] += w[j][2] * bf_lo(x_.y); v[3] += w[j][3] * bf_hi(x_.y);
                v[4] += w[j][4] * bf_lo(x_.z); v[5] += w[j][5] * bf_hi(x_.z); v[6] += w[j][6] * bf_lo(x_.w); v[7] += w[j][7] * bf_hi(x_.w); }
            if (act) {
#pragma unroll
                for (int i = 0; i < 8; ++i) v[i] = siluf_(v[i]) * qs;
            }
            const int pq = pf0 + o; const int tj = cm ? ((pq & 31) * 64 + (pq >> 5)) : pq;
            u32x4 wv; wv.x = pk2(v[0], v[1]); wv.y = pk2(v[2], v[3]); wv.z = pk2(v[4], v[5]); wv.w = pk2(v[6], v[7]);
            st16_wt(CV + (size_t)(base + tj) * PALD + c0, wv);
        }
    }
}

template <int MODE>
__device__ __forceinline__ void seq_unit(const Params& p, LAS unsigned char* L, int l, int b, int hd, int d) {
    const int tid = tid_opaque(), lane = tid & 63, wave = __builtin_amdgcn_readfirstlane(tid >> 6);
    const int r16 = lane & 15, q4 = lane >> 4;
    const int wpar = wave & 1, w8 = (wave >> 1) * 16;
    constexpr int OB = 40960, LSV = 88;
    LAS bf16_t* sS = (LAS bf16_t*)(L + 81920); LAS bf16_t* sC = (LAS bf16_t*)(L + 91136);
    LAS float* tabG = (LAS float*)(L + 114176); LAS float* tabM = (LAS float*)(L + 123392); LAS float* tabB = (LAS float*)(L + 132608);
    LAS bf16_t* sO = (LAS bf16_t*)(L + 142336);
    LAS float* rden = (LAS float*)(L + 141824);
    const bf16_t* CV = (const bf16_t*)(p.ws + WS_CV);
    const float* G = (const float*)(p.ws + WS_GATES);
    bf16_t* outp = (bf16_t*)(p.ws + (d ? WS_RAWB : WS_XN));
    const bf16_t* P2; int ld2;
    int col0, col1, col2, ocol, gc0, gc1 = 0; float gb0, gb1 = 0.f, Aneg = 0.f, dskip = 0.f;
    if (MODE == 0) { col0 = hd * 64; col1 = 256 + hd * 64; col2 = hd * 64; P2 = (const bf16_t*)(p.ws + WS_PR); ld2 = PRLD; ocol = hd * 64; gc0 = d * 4 + hd; gc1 = 8 + d * 4 + hd;
        gb0 = p.in[I_BIG][(l * 2 + d) * 4 + hd]; gb1 = p.in[I_BFG][(l * 2 + d) * 4 + hd]; }
    else { const int g = hd >> 2; col0 = 1152 + g * 64; col1 = 1024 + g * 64; col2 = 512 + hd * 64; P2 = CV; ld2 = PALD; ocol = 256 + hd * 64; gc0 = 16 + d * 8 + hd;
        gb0 = p.in[I_DTB][(l * 2 + d) * 8 + hd]; Aneg = -__expf(p.in[I_ALOG][(l * 2 + d) * 8 + hd]); dskip = p.in[I_DSKIP][l * 8 + hd]; }
    __syncthreads();
    for (int i = tid; i < 80 * LS / 2; i += NTHREADS) ((LAS unsigned*)sC)[i] = 0u;
    if (MODE == 0 && tid < 128) { LAS unsigned char* ob = L + (tid >> 6) * OB; const int row = tid & 63;
        unsigned z_ = 0u, o_ = 0x00003F80u; asm volatile("" : "+v"(z_), "+v"(o_));
        const u32x4 zz_ = {z_, z_, z_, z_}, oo_ = {o_, z_, z_, z_};
        *(LAS u32x4*)(ob + 18432 + (row * LSV + 64) * 2) = oo_; *(LAS u32x4*)(ob + 18432 + (row * LSV + 72) * 2) = zz_;
        *(LAS u32x4*)(ob + 29696 + (row * LSV + 64) * 2) = zz_; *(LAS u32x4*)(ob + 29696 + (row * LSV + 72) * 2) = zz_; }
    for (int c = wave; c < 36; c += 8) {
        const bool isctx = c < 4; const int cc = isctx ? c : c - 4; const int Lseg = isctx ? CTXL : SEQL; const int base = isctx ? RL + b * CTXL : b * SEQL;
        const int pos0 = cc * 64 + lane; const int tau0 = d ? Lseg - 1 - pos0 : pos0; const float* gp = G + (size_t)(base + tau0) * 32;
        if (MODE == 0) {
            const float ig = gp[gc0] + gb0, fg = gp[gc1] + gb1;
            const float lf = fminf(fg, 0.f) - log1pf(__expf(-fabsf(fg)));
            float bs = lf;
#pragma unroll
            for (int o = 1; o < 64; o <<= 1) { const float t = __shfl_up(bs, o); if (lane >= o) bs += t; }
            const float g = ig - bs; float M = g;
#pragma unroll
            for (int o = 1; o < 64; o <<= 1) { const float t = __shfl_up(M, o); if (lane >= o) M = fmaxf(M, t); }
            tabG[c * 64 + lane] = g; tabM[c * 64 + lane] = M; tabB[c * 64 + lane] = bs;
        } else {
            const float dtv = softplusf_(gp[gc0] + gb0);
            float cs = dtv * Aneg;
#pragma unroll
            for (int o = 1; o < 64; o <<= 1) { const float t = __shfl_up(cs, o); if (lane >= o) cs += t; }
            tabG[c * 64 + lane] = cs; tabM[c * 64 + lane] = dtv;
        }
    }
    f32x4 st[2] = {{0.f, 0.f, 0.f, 0.f}, {0.f, 0.f, 0.f, 0.f}};
    f32x4 stx = {0.f, 0.f, 0.f, 0.f};
    f32x4 res[2] = {{0.f, 0.f, 0.f, 0.f}, {0.f, 0.f, 0.f, 0.f}};
    float m_in = 0.f;
    u32x4 r0, r1, r2, r3, r4, r5;
#define PREFETCH(CN) do { const int cn_ = (CN); const bool isctx_ = cn_ < 4; const int cc_ = isctx_ ? cn_ : cn_ - 4; const int Lseg_ = isctx_ ? CTXL : SEQL; const int base_ = isctx_ ? RL + b * CTXL : b * SEQL; \
        const int pos_ = cc_ * 64 + lane; const int row_ = base_ + (d ? Lseg_ - 1 - pos_ : pos_); \
        r0 = *(const u32x4*)(CV + (size_t)row_ * PALD + col0 + w8); r1 = *(const u32x4*)(CV + (size_t)row_ * PALD + col1 + w8); r2 = *(const u32x4*)(P2 + (size_t)row_ * ld2 + col2 + w8); \
        r3 = *(const u32x4*)(CV + (size_t)row_ * PALD + col0 + w8 + 8); r4 = *(const u32x4*)(CV + (size_t)row_ * PALD + col1 + w8 + 8); r5 = *(const u32x4*)(P2 + (size_t)row_ * ld2 + col2 + w8 + 8); } while (0)
#define WRITEOUT(CP) do { const int cp_ = (CP); const bool isctx_ = cp_ < 4; const int cc_ = isctx_ ? cp_ : cp_ - 4; const int Lseg_ = isctx_ ? CTXL : SEQL; const int base_ = isctx_ ? RL + b * CTXL : b * SEQL; \
        const int tok_ = tid >> 3, grp_ = (tid & 7) * 8; const int pos_ = cc_ * 64 + tok_; const int row_ = base_ + (d ? Lseg_ - 1 - pos_ : pos_); \
        st16_wt(outp + (size_t)row_ * D + ocol + grp_, *(const LAS u32x4*)(sO + tok_ * LS + grp_)); } while (0)
    r0 = r1 = r2 = r3 = r4 = r5 = (u32x4){0u, 0u, 0u, 0u};
    if (wpar == 0) PREFETCH(0); else PREFETCH(1);
    __syncthreads();
    for (int c = -1; c < 36; ++c) {
        const int cur = c & 1;
        LAS unsigned char* Oc = L + cur * OB; LAS unsigned char* On = L + (cur ^ 1) * OB;
        LAS bf16_t* sQ = (LAS bf16_t*)Oc; LAS bf16_t* sK = (LAS bf16_t*)(Oc + 9216); LAS bf16_t* sV = (LAS bf16_t*)(Oc + 18432); LAS bf16_t* sWV = (LAS bf16_t*)(Oc + 29696);
        const LAS float* tg = tabG + (c < 0 ? 0 : c) * 64; const LAS float* tm = tabM + (c < 0 ? 0 : c) * 64; const LAS float* tb = tabB + (c < 0 ? 0 : c) * 64;
        float m_out = 0.f, decay = 1.f;
        if (c >= 0) {
            if (MODE == 0) { const float mm_end = fmaxf(m_in, tm[63]); decay = __expf(m_in - mm_end); m_out = tb[63] + mm_end; }
            else decay = __expf(tg[63]);
#pragma unroll
            for (int i = 0; i < 2; ++i) { const int idx = wave + 8 * i, stile = idx >> 2, ttile = idx & 3;
                f32x4 acc = {0.f, 0.f, 0.f, 0.f}; acc = mma64(sK + stile * 16 * LS, sQ + ttile * 16 * LS, lane, acc);
                const int t = ttile * 16 + r16, s0 = stile * 16 + 4 * q4;
                const float bt = (MODE == 0) ? -fmaxf(m_in, tm[t]) : tg[t];
                float o[4];
#pragma unroll
                for (int j = 0; j < 4; ++j) { const int s = s0 + j;
                    const float e = (MODE == 0) ? __expf(tg[s] + bt) : __expf(bt - tg[s]) * tm[s];
                    o[j] = (s <= t) ? acc[j] * e : 0.f; }
                u32x2 w; w.x = pk2(o[0], o[1]); w.y = pk2(o[2], o[3]); *(LAS u32x2*)(sS + t * LS + s0) = w; }
        }
        LDS_BARRIER();
        if (c >= 1) WRITEOUT(c - 1);
        if (c >= 0) {
            LAS bf16_t* sCc = sC + cur * 80 * LS; LAS bf16_t* sCn = sC + (cur ^ 1) * 80 * LS;
#pragma unroll
            for (int i = 0; i < 2; ++i) { const int idx = wave + 8 * i, vtile = idx >> 2, ttile = idx & 3; const int t = ttile * 16 + r16;
                f32x4 a = {0.f, 0.f, 0.f, 0.f}; a = mma64(sCc + vtile * 16 * LS, sQ + ttile * 16 * LS, lane, a);
                const float dl = (MODE == 0) ? __expf(m_in - fmaxf(m_in, tm[t])) : __expf(tg[t]);
                a = a * dl;
#pragma unroll
                for (int kk = 0; kk < 2; ++kk) { const bf16x8 fa = tr_frag(sV, LSV, vtile, kk, lane); const bf16x8 fb = *(const LAS bf16x8*)(sS + (ttile * 16 + r16) * LS + kk * 32 + q4 * 8);
                    a = __builtin_amdgcn_mfma_f32_16x16x32_bf16(fa, fb, a, 0, 0, 0); }
                res[i] = a; }
            if (MODE == 0 && wave < 4) { const int t = wave * 16 + r16;
                f32x4 a = {0.f, 0.f, 0.f, 0.f}; a = mma64(sCc + 64 * LS, sQ + wave * 16 * LS, lane, a);
                a = a * __expf(m_in - fmaxf(m_in, tm[t]));
#pragma unroll
                for (int kk = 0; kk < 2; ++kk) { const bf16x8 fa = tr_frag(sV, LSV, 4, kk, lane); const bf16x8 fb = *(const LAS bf16x8*)(sS + (wave * 16 + r16) * LS + kk * 32 + q4 * 8);
                    a = __builtin_amdgcn_mfma_f32_16x16x32_bf16(fa, fb, a, 0, 0, 0); }
                if (q4 == 0) rden[t] = a[0]; }
#pragma unroll
            for (int i = 0; i < 2; ++i) { const int idx = wave + 8 * i, ktile = idx >> 2, vtile = idx & 3;
                f32x4 a = st[i] * decay;
#pragma unroll
                for (int kk = 0; kk < 2; ++kk) { const bf16x8 fa = tr_frag(sK, LS, ktile, kk, lane); const bf16x8 fb = tr_frag(sWV, LSV, vtile, kk, lane);
                    a = __builtin_amdgcn_mfma_f32_16x16x32_bf16(fa, fb, a, 0, 0, 0); }
                st[i] = a;
                u32x2 w; w.x = pk2(a[0], a[1]); w.y = pk2(a[2], a[3]); *(LAS u32x2*)(sCn + (vtile * 16 + r16) * LS + ktile * 16 + 4 * q4) = w; }
            if (MODE == 0 && wave >= 4) { const int ktile = wave - 4;
                f32x4 a = stx * decay;
#pragma unroll
                for (int kk = 0; kk < 2; ++kk) { const bf16x8 fa = tr_frag(sK, LS, ktile, kk, lane); const bf16x8 fb = tr_frag(sWV, LSV, 4, kk, lane);
                    a = __builtin_amdgcn_mfma_f32_16x16x32_bf16(fa, fb, a, 0, 0, 0); }
                stx = a;
                u32x2 w; w.x = pk2(a[0], a[1]); w.y = pk2(a[2], a[3]); *(LAS u32x2*)(sCn + (64 + r16) * LS + ktile * 16 + 4 * q4) = w; }
        }
        if (c + 1 < 36 && ((c + 1) & 1) == wpar) {
            const int cn = c + 1;
            LAS bf16_t* nQ = (LAS bf16_t*)On; LAS bf16_t* nK = (LAS bf16_t*)(On + 9216); LAS bf16_t* nV = (LAS bf16_t*)(On + 18432); LAS bf16_t* nWV = (LAS bf16_t*)(On + 29696);
            float om;
            if (MODE == 0) om = __expf(tabG[cn * 64 + lane] - fmaxf(m_out, tabM[cn * 64 + 63]));
            else om = __expf(tabG[cn * 64 + 63] - tabG[cn * 64 + lane]) * tabM[cn * 64 + lane];
            if (MODE == 0 && (wave >> 1) == 0) nWV[lane * LSV + 64] = (bf16_t)f2bf(om);
            *(LAS u32x4*)(nQ + lane * LS + w8) = r0; *(LAS u32x4*)(nQ + lane * LS + w8 + 8) = r3;
            *(LAS u32x4*)(nK + lane * LS + w8) = r1; *(LAS u32x4*)(nK + lane * LS + w8 + 8) = r4;
            *(LAS u32x4*)(nV + lane * LSV + w8) = r2; *(LAS u32x4*)(nV + lane * LSV + w8 + 8) = r5;
            { u32x4 wv; wv.x = pk2(bf_lo(r2.x) * om, bf_hi(r2.x) * om); wv.y = pk2(bf_lo(r2.y) * om, bf_hi(r2.y) * om); wv.z = pk2(bf_lo(r2.z) * om, bf_hi(r2.z) * om); wv.w = pk2(bf_lo(r2.w) * om, bf_hi(r2.w) * om);
              *(LAS u32x4*)(nWV + lane * LSV + w8) = wv;
              wv.x = pk2(bf_lo(r5.x) * om, bf_hi(r5.x) * om); wv.y = pk2(bf_lo(r5.y) * om, bf_hi(r5.y) * om); wv.z = pk2(bf_lo(r5.z) * om, bf_hi(r5.z) * om); wv.w = pk2(bf_lo(r5.w) * om, bf_hi(r5.w) * om);
              *(LAS u32x4*)(nWV + lane * LSV + w8 + 8) = wv; }
            if (c + 3 < 36) PREFETCH(c + 3);
        }
        LDS_BARRIER();
        if (c >= 0) {
            const bool isctx = c < 4; const int cc = isctx ? c : c - 4; const int Lseg = isctx ? CTXL : SEQL; const int base = isctx ? RL + b * CTXL : b * SEQL;
#pragma unroll
            for (int i = 0; i < 2; ++i) { const int idx = wave + 8 * i, vtile = idx >> 2, ttile = idx & 3; const int t = ttile * 16 + r16, v0 = vtile * 16 + 4 * q4;
                f32x4 a = res[i];
                if (MODE == 0) { const float mmt = fmaxf(m_in, tm[t]); const float dn = rden[t]; a = a * __builtin_amdgcn_rcpf(fmaxf(fabsf(dn), __expf(-(tb[t] + mmt)))); }
                else if (d == 0) {
#pragma unroll
                    for (int j = 0; j < 1; ++j) { const u32x2 xv = *(const LAS u32x2*)(sV + t * LSV + v0); a[0] += dskip * bf_lo(xv.x); a[1] += dskip * bf_hi(xv.x); a[2] += dskip * bf_lo(xv.y); a[3] += dskip * bf_hi(xv.y); } }
                u32x2 w; w.x = pk2(a[0], a[1]); w.y = pk2(a[2], a[3]);
                *(LAS u32x2*)(sO + t * LS + v0) = w; }
        }
        m_in = m_out;
    }
    LDS_BARRIER();
    WRITEOUT(35);
#undef WRITEOUT
#undef PREFETCH
}

__device__ __forceinline__ void rg_unit(const Params& p, LAS unsigned char* L, int l, int b, int n, int d) {
    const int tid = tid_opaque(), lane = tid & 63, wave = __builtin_amdgcn_readfirstlane(tid >> 6);
    const int tt = tid >> 3, cg8 = (tid & 7) * 8, r16 = lane & 15, q4 = lane >> 4;
    LAS bf16_t* sXb = (LAS bf16_t*)(L + 0); LAS bf16_t* sWt = (LAS bf16_t*)(L + 9216);
    LAS float* sXf = (LAS float*)(L + 27648); LAS float* sA = (LAS float*)(L + 44288); LAS float* sU = (LAS float*)(L + 60928); LAS float* sH = (LAS float*)(L + 77568);
    LAS float* sv = (LAS float*)(L + 95488);
    LAS float* sSeg = (LAS float*)(L + 96256);
    const bf16_t* CV = (const bf16_t*)(p.ws + WS_CV);
    bf16_t* outp = (bf16_t*)(p.ws + (d ? WS_RAWB : WS_XN));
    __syncthreads();
    for (int i = tid; i < 2 * 64 * 64; i += NTHREADS) { const int g = i >> 12, c = (i >> 6) & 63, dd = i & 63;
        const float v = p.in[I_WRG][((size_t)((((l * 2 + d) * 2 + g) * 4 + n) * 64 + c)) * 64 + dd]; sWt[(g * 64 + dd) * LS + c] = (bf16_t)f2bf(v); }
    if (tid < 64) { sv[tid] = p.in[I_BRG][((l * 2 + d) * 2 + 0) * 256 + n * 64 + tid]; sv[64 + tid] = p.in[I_BRG][((l * 2 + d) * 2 + 1) * 256 + n * 64 + tid];
        sv[128 + tid] = softplusf_(-p.in[I_LAM][(l * 2 + d) * 256 + n * 64 + tid]); }
    float hstate = 0.f;
    u32x4 rx = {0u, 0u, 0u, 0u};
    for (int c = -1; c < 36; ++c) {
        if (c >= 0) {
            float v[8] = {bf_lo(rx.x), bf_hi(rx.x), bf_lo(rx.y), bf_hi(rx.y), bf_lo(rx.z), bf_hi(rx.z), bf_lo(rx.w), bf_hi(rx.w)};
            *(LAS u32x4*)(sXb + tt * LS + cg8) = rx;
#pragma unroll
            for (int i = 0; i < 8; ++i) sXf[tt * 65 + cg8 + i] = v[i];
            LDS_BARRIER();
        }
        if (c + 1 < 36) {
            const int cn = c + 1; const bool isctx = cn < 4; const int cc = isctx ? cn : cn - 4; const int Lseg = isctx ? CTXL : SEQL;
            const int pos = cc * 64 + tt; const int pf = d ? Lseg - 1 - pos : pos;
            const int row = isctx ? RL + b * CTXL + pf : b * SEQL + (pf & 31) * 64 + (pf >> 5);
            rx = *(const u32x4*)(CV + (size_t)row * PALD + 1280 + n * 64 + cg8);
        }
        if (c >= 0) {
            { const int jt = wave & 3, dp = wave >> 2;
#pragma unroll
              for (int i = 0; i < 2; ++i) { const int dtile = 2 * dp + i;
                  f32x4 a0 = {0.f, 0.f, 0.f, 0.f}, a1 = {0.f, 0.f, 0.f, 0.f};
                  a0 = mma64(sXb + jt * 16 * LS, sWt + (dtile * 16) * LS, lane, a0);
                  a1 = mma64(sXb + jt * 16 * LS, sWt + (64 + dtile * 16) * LS, lane, a1);
                  const int dd = dtile * 16 + r16, j0 = jt * 16 + 4 * q4; const float br = sv[dd], bi = sv[64 + dd], sp = sv[128 + dd];
#pragma unroll
                  for (int jj = 0; jj < 4; ++jj) { const float rr = sigmoidf_(a0[jj] + br), ii = sigmoidf_(a1[jj] + bi); const float la = -8.f * rr * sp;
                      const float a = __expf(la); const float u = __builtin_amdgcn_sqrtf(fmaxf(1.f - a * a, 0.f)) * ii * sXf[(j0 + jj) * 65 + dd];
                      sA[(j0 + jj) * 65 + dd] = a; sU[(j0 + jj) * 65 + dd] = u; } } }
            LDS_BARRIER();
            { float pp[8], uu[8]; float P = 1.f, U = 0.f;
#pragma unroll
              for (int j = 0; j < 8; ++j) { const float a = sA[(wave * 8 + j) * 65 + lane], u = sU[(wave * 8 + j) * 65 + lane]; P = a * P; U = a * U + u; pp[j] = P; uu[j] = U; }
              sSeg[wave * 64 + lane] = P; sSeg[512 + wave * 64 + lane] = U;
              LDS_BARRIER();
              float h = hstate, hin = hstate;
#pragma unroll
              for (int s = 0; s < 8; ++s) { if (s == wave) hin = h; h = sSeg[s * 64 + lane] * h + sSeg[512 + s * 64 + lane]; }
              hstate = h;
#pragma unroll
              for (int j = 0; j < 8; ++j) sH[(wave * 8 + j) * 65 + lane] = pp[j] * hin + uu[j]; }
            LDS_BARRIER();
            { const bool isctx = c < 4; const int cc = isctx ? c : c - 4; const int Lseg = isctx ? CTXL : SEQL;
              const int pos = cc * 64 + tt; const int pf = d ? Lseg - 1 - pos : pos;
              const int row = isctx ? RL + b * CTXL + pf : b * SEQL + (pf & 31) * 64 + (pf >> 5);
              const LAS float* hp = sH + tt * 65 + cg8;
              u32x4 w; w.x = pk2(hp[0], hp[1]); w.y = pk2(hp[2], hp[3]); w.z = pk2(hp[4], hp[5]); w.w = pk2(hp[6], hp[7]);
              st16_wt(outp + (size_t)row * D + 768 + n * 64 + cg8, w); }
        }
    }
}
__device__ __forceinline__ void scan_phase(const Params& p, LAS unsigned char* L, int l) {
    for (int u = blockIdx.x; u < 256; u += gridDim.x) {
        if (u < 64) seq_unit<0>(p, L, l, u >> 3, (u & 7) >> 1, u & 1);
        else if (u < 192) { const int v = u - 64; seq_unit<1>(p, L, l, v >> 4, (v & 15) >> 1, v & 1); }
        else { const int v = u - 192; rg_unit(p, L, l, v >> 3, (v & 7) >> 1, v & 1); }
    }
}

__global__ void __launch_bounds__(NTHREADS, 2) fwd_kernel(Params p) {
    extern __shared__ __attribute__((aligned(16))) unsigned char lds_raw[];
    LAS unsigned char* L = (LAS unsigned char*)lds_raw;
    if (threadIdx.x < 4) ((LAS unsigned*)(L + LDS_BARST))[threadIdx.x] = 0u;
    __syncthreads();
    (void)xcd_barrier_post((unsigned*)(p.ws + WS_CTL), (volatile LAS unsigned*)(L + LDS_BARST));
#pragma unroll 1
    for (int ph = p.lo; ph < p.hi; ++ph) {
        Params pl = p; { unsigned char* w_ = pl.ws; asm volatile("" : "+s"(w_)); pl.ws = w_; }
        if (ph == 0) phase0(pl, L);
        else if (ph == NPHASES - 1) final_phase(pl);
        else {
            const int l = (ph - 1) / 10, k = (ph - 1) - 10 * l;
            if (k == 9 && l == 1) continue;
            if (k == 0) normmod_phase(pl, l, 0);
            else if (k == 6) normmod_phase(pl, l, 1);
            else if (k == 2) conv_phase(pl, L, l);
            else if (k == 3) scan_phase(pl, L, l);
            else if (k == 4) finalize_phase(pl, l, l == 0 ? RT : RL);
            else {
                const unsigned char* wt = pl.ws + WS_WT + (size_t)l * WT_LAYER;
                const int Mrest = l == 0 ? RT : RL;
                pg8::Gemm g; EpiAll E; E.pp = &pl; E.l = l; Order S; S.nslice = 0;
                if (k == 1)      { g.A = (const pg8::bf16_t*)(pl.ws + WS_XN); g.Bt = (const pg8::bf16_t*)wt;            g.M = RT;    g.N = PINP; g.K = D;  g.ld = D;  E.kind = 0; }
                else if (k == 5) { g.A = (const pg8::bf16_t*)(pl.ws + WS_XN); g.Bt = (const pg8::bf16_t*)(wt + WT_OUT); g.M = Mrest; g.N = D;    g.K = D;  g.ld = D;  E.kind = 1; }
                else if (k == 7) { g.A = (const pg8::bf16_t*)(pl.ws + WS_XN); g.Bt = (const pg8::bf16_t*)(wt + WT_W1);  g.M = Mrest; g.N = FF;   g.K = D;  g.ld = D;  E.kind = 2; }
                else if (k == 8) { g.A = (const pg8::bf16_t*)(pl.ws + WS_H);  g.Bt = (const pg8::bf16_t*)(wt + WT_W2);  g.M = RL;    g.N = D;    g.K = FF; g.ld = FF; E.kind = 3; }
                else             { g.A = (const pg8::bf16_t*)(pl.ws + WS_H) + (size_t)RL * FF; g.Bt = (const pg8::bf16_t*)(wt + WT_W2); g.M = RC; g.N = D; g.K = FF / 4; g.ld = FF; E.kind = 4; S.nslice = 4; }
                S.so.init(g.M, g.N, (int)gridDim.x, (int)blockIdx.x);
                pg8::gemm_phase<EpiAll, Order, true, true>(L, g, S, E);
            }
        }
        if (ph + 1 < p.hi) { XcdBarrier bar; bar.bar = (unsigned*)(pl.ws + WS_CTL); bar.x = xb_xcc_id(); bar.st = (volatile LAS unsigned*)(L + LDS_BARST); xcd_barrier(bar); }
    }
}

extern "C" void kernel_launch(void* const* d_in, const int* in_sizes, int n_in, void* d_out, int out_size, void* d_ws, size_t ws_size, hipStream_t stream) {
    static int grid = 0;
    if (grid == 0) {
        if (n_in != 31 || out_size != RL * D || ws_size < WS_END) { fprintf(stderr, "kernel_launch: unexpected problem (n_in %d out %d ws %zu)\n", n_in, out_size, ws_size); grid = -1; return; }
        int dev = 0, cus = 0, per_cu = 0;
        (void)hipGetDevice(&dev); (void)hipDeviceGetAttribute(&cus, hipDeviceAttributeMultiprocessorCount, dev);
        if (hipFuncSetAttribute((const void*)fwd_kernel, hipFuncAttributeMaxDynamicSharedMemorySize, LDS_BYTES) != hipSuccess) { fprintf(stderr, "kernel_launch: hipFuncSetAttribute failed\n"); grid = -1; return; }
        if (hipOccupancyMaxActiveBlocksPerMultiprocessor(&per_cu, (const void*)fwd_kernel, NTHREADS, LDS_BYTES) != hipSuccess || per_cu < 1) { fprintf(stderr, "kernel_launch: occupancy query says %d\n", per_cu); per_cu = 1; }
        (void)hipGetLastError();
        if (per_cu > 1) per_cu = 1;
        grid = cus * per_cu;
        if (grid > 256) grid = 256;
    }
    if (grid < 0) return;
    Params p{};
    for (int i = 0; i < 31; ++i) p.in[i] = (const float*)d_in[i];
    p.out = (float*)d_out; p.ws = (unsigned char*)d_ws;
    (void)hipMemsetAsync((unsigned char*)d_ws + WS_CTL, 0, CTL_BYTES, stream);
#if MK_N_LAUNCHES == 1
    p.lo = 0; p.hi = NPHASES;
    hipLaunchKernelGGL(fwd_kernel, dim3(grid), dim3(NTHREADS), LDS_BYTES, stream, p);
    hipError_t e = hipPeekAtLastError();
    if (e != hipSuccess) fprintf(stderr, "launch failed: %s (grid %d)\n", hipGetErrorString(e), grid);
#else
    for (int k = 0; k < NPHASES; ++k) { p.lo = k; p.hi = k + 1; hipLaunchKernelGGL(fwd_kernel, dim3(grid), dim3(NTHREADS), LDS_BYTES, stream, p); }
#endif
}
```

```cpp
#include <hip/hip_runtime.h>
#include <hip/hip_cooperative_groups.h>
#include <cstdio>
#include <cstdint>
namespace cg = cooperative_groups;
__device__ __forceinline__ int tid_opaque() { int t = threadIdx.x; asm volatile("" : "+v"(t)); return t; }
namespace pg8 {
#define PG8_LAS __attribute__((address_space(3)))
typedef unsigned short bf16_t;
typedef short bf16x8 __attribute__((ext_vector_type(8)));
typedef float f32x4 __attribute__((ext_vector_type(4)));
typedef unsigned u32x4 __attribute__((ext_vector_type(4)));
constexpr int BM = 256, BK = 64, HALF = 128, HTB = HALF * BK * 2  , STAGE_BYTES = 8 * HTB, NXCD = 8, WGM = 8;

__host__ __device__ __forceinline__ int lds_byte(int r, int c) { const int st = (r >> 4) * 2 + (c >> 5), rr = r & 15, cc = c & 31, ob = rr * 64 + cc * 2; return st * 1024 + (ob ^ (((ob >> 9) & 1) << 5)); }
__host__ __device__ __forceinline__ void stage_rc(int b, int& R, int& C) { const int st = b / 1024, sb = b % 1024, swz = sb ^ (((sb >> 9) & 1) << 5); R = (st >> 1) * 16 + swz / 64; C = (st & 1) * 32 + (swz % 64) / 2; }
__host__ __device__ __forceinline__ int perm32(int rho) { const int n = rho >> 4, i = rho & 15; return 8 * (i >> 2) + 4 * n + (i & 3); }

struct Unit { int pm, pn, ks; };
struct Gemm { const bf16_t* A; const bf16_t* Bt; int M, N, K, ld; };

struct StaticOrder {
    int nM, nN, nwg, G, c;
    __host__ __device__ void init(int M, int N, int G_, int c_) { nM = M / BM; nN = N / BM; nwg = nM * nN; G = G_; c = c_; }
    __host__ __device__ bool next(int i, Unit& u) const {
        const long L = (long)i * G + c; if (L >= nwg) return false;
        int wgid = (int)L; { const int q = nwg / NXCD, r = nwg % NXCD, xcd = wgid % NXCD, off = wgid / NXCD; wgid = (xcd < r ? xcd * (q + 1) : r * (q + 1) + (xcd - r) * q) + off; }
        const int nig = WGM * nN, gid = wgid / nig, fm = gid * WGM, gsz = (nM - fm) < WGM ? (nM - fm) : WGM;
        u.pm = fm + ((wgid % nig) % gsz); u.pn = (wgid % nig) / gsz; u.ks = 0; return true;
    }
    __device__ __forceinline__ void a_ready(const Unit&) const {}
    __device__ __forceinline__ void done(const Unit&) const {}
};

__device__ __forceinline__ unsigned cvt_pk_bf16(float lo, float hi) { unsigned r; asm volatile("v_cvt_pk_bf16_f32 %0, %1, %2" : "=v"(r) : "v"(lo), "v"(hi)); return r; }
typedef float f32x2 __attribute__((ext_vector_type(2)));
template <class Epi, class Sched, bool ALIGN_EPI = false, bool SP2 = false>
__device__ __forceinline__ void gemm_phase(PG8_LAS unsigned char* lds, const Gemm g, const Sched& S, const Epi& E) {
    const int tid = tid_opaque(), wid = __builtin_amdgcn_readfirstlane(tid >> 6), lane = tid & 63, wr = wid >> 2, wc = wid & 3, fr = lane & 15, fq = lane >> 4;
    const int K = g.K, nt = K / BK, ld = g.ld;
    unsigned voffA[2], voffB[2];
#pragma unroll
    for (int i = 0; i < 2; ++i) { int R, C; stage_rc(tid * 16 + i * 8192, R, C); const int Rb = Epi::PERM ? ((R & ~31) + perm32(R & 31)) : R;
        voffA[i] = (unsigned)(R * ld + C) * 2u; voffB[i] = (unsigned)(Rb * ld + C) * 2u; }
    const size_t kstep = (size_t)(BK * 2);
    const size_t hstep = (size_t)HALF * ld * 2;
    const size_t tstep = 2 * hstep;
    const unsigned ldsw = (unsigned)wid * 1024u;
    const int aoff = lds_byte(wr * 64 + fr, fq * 8), boff = lds_byte(wc * 32 + fr, fq * 8);
#define PG8_SA(b, h) (((b) * 2 + (h)) * HTB)
#define PG8_SB(b, h) ((4 + (b) * 2 + (h)) * HTB)
#define PG8_STAGE(bufoff, gbase, voff) do { _Pragma("unroll") for (int _i = 0; _i < 2; ++_i) \
        __builtin_amdgcn_global_load_lds((const unsigned*)((const char*)(gbase) + (voff)[_i]), (PG8_LAS unsigned*)(lds + (bufoff) + ldsw + _i * 8192), 16, 0, 0); } while (0)
#define PG8_LDA(dst, b, h) do { _Pragma("unroll") for (int m = 0; m < 4; ++m) _Pragma("unroll") for (int k = 0; k < 2; ++k) dst[m][k] = *(const PG8_LAS bf16x8*)(lds + PG8_SA(b, h) + aoff + m * 2048 + k * 1024); } while (0)
#define PG8_LDB(dst, b, h) do { _Pragma("unroll") for (int n = 0; n < 2; ++n) _Pragma("unroll") for (int k = 0; k < 2; ++k) dst[n][k] = *(const PG8_LAS bf16x8*)(lds + PG8_SB(b, h) + boff + n * 2048 + k * 1024); } while (0)
#define PG8_MMA(ai, bj, At, Bt) do { __builtin_amdgcn_s_setprio(1); _Pragma("unroll") for (int m = 0; m < 4; ++m) _Pragma("unroll") for (int n = 0; n < 2; ++n) _Pragma("unroll") for (int k = 0; k < 2; ++k) \
        acc[ai][bj][m][n] = __builtin_amdgcn_mfma_f32_16x16x32_bf16(Bt[n][k], At[m][k], acc[ai][bj][m][n], 0, 0, 0); __builtin_amdgcn_s_setprio(0); } while (0)
#define PG8_WAIT_V(n) asm volatile("s_waitcnt vmcnt(" #n ")" ::: "memory")
#define PG8_WAIT_L(n) asm volatile("s_waitcnt lgkmcnt(" #n ")" ::: "memory")
#define PG8_BAR __builtin_amdgcn_s_barrier()
#define PG8_SCHED __builtin_amdgcn_sched_barrier(0)
    Unit cur, nxt; int ui = 0;
    if (!S.next(0, cur)) return;
    f32x4 acc[2][2][4][2];
#pragma unroll
    for (int a = 0; a < 2; ++a)
#pragma unroll
        for (int b = 0; b < 2; ++b)
#pragma unroll
            for (int m = 0; m < 4; ++m)
#pragma unroll
                for (int n = 0; n < 2; ++n) acc[a][b][m][n] = (f32x4){0.f, 0.f, 0.f, 0.f};
    bf16x8 At[4][2], B0[2][2], B1[2][2];
    const size_t sstep = (size_t)K * 2;
    const char* cA = (const char*)g.A + (size_t)cur.pm * tstep + (size_t)cur.ks * sstep; const char* cB = (const char*)g.Bt + (size_t)cur.pn * tstep + (size_t)cur.ks * sstep;
    S.a_ready(cur);
    if constexpr (SP2) {
        PG8_STAGE(PG8_SB(0, 0), cB, voffB); PG8_STAGE(PG8_SB(0, 1), cB + hstep, voffB); PG8_STAGE(PG8_SA(0, 0), cA, voffA); PG8_STAGE(PG8_SA(0, 1), cA + hstep, voffA);
        if (wr == 1) PG8_BAR;
        PG8_WAIT_V(2); PG8_BAR;
        PG8_STAGE(PG8_SB(1, 0), cB + kstep, voffB); PG8_STAGE(PG8_SA(1, 0), cA + kstep, voffA); PG8_STAGE(PG8_SB(1, 1), cB + hstep + kstep, voffB);
        PG8_WAIT_V(6); PG8_BAR;
    } else {
        PG8_STAGE(PG8_SB(0, 0), cB, voffB); PG8_STAGE(PG8_SA(0, 0), cA, voffA); PG8_STAGE(PG8_SB(0, 1), cB + hstep, voffB); PG8_STAGE(PG8_SA(0, 1), cA + hstep, voffA);
        if (wr == 1) PG8_BAR;
        PG8_WAIT_V(4); PG8_BAR;
        PG8_STAGE(PG8_SB(1, 0), cB + kstep, voffB); PG8_STAGE(PG8_SA(1, 0), cA + kstep, voffA); PG8_STAGE(PG8_SB(1, 1), cB + hstep + kstep, voffB);
        PG8_WAIT_V(6); PG8_BAR;
    }
    for (;;) {
        const bool has_next = S.next(ui + 1, nxt);
        const char* nA = has_next ? (const char*)g.A + (size_t)nxt.pm * tstep + (size_t)nxt.ks * sstep : cA; const char* nB = has_next ? (const char*)g.Bt + (size_t)nxt.pn * tstep + (size_t)nxt.ks * sstep : cB;
        for (int t = 0; t < nt; t += 2) {
            const bool last = (t == nt - 2);
            const char* a1 = cA + (size_t)(t + 1) * kstep;
            const char* a2 = last ? nA : cA + (size_t)(t + 2) * kstep; const char* b2 = last ? nB : cB + (size_t)(t + 2) * kstep;
            const char* a3 = a2 + kstep; const char* b3 = b2 + kstep;
            if (last && has_next) S.a_ready(nxt);
            if constexpr (SP2) {
            PG8_LDB(B0, 0, 0); PG8_LDB(B1, 0, 1); PG8_SCHED; PG8_LDA(At, 0, 0); PG8_STAGE(PG8_SA(1, 1), a1 + hstep, voffA);
            PG8_WAIT_V(8); PG8_WAIT_L(0); PG8_BAR; PG8_MMA(0, 0, At, B0); PG8_MMA(0, 1, At, B1); PG8_BAR; PG8_SCHED;
            PG8_LDA(At, 0, 1); PG8_STAGE(PG8_SB(0, 0), b2, voffB); PG8_STAGE(PG8_SB(0, 1), b2 + hstep, voffB); PG8_STAGE(PG8_SA(0, 0), a2, voffA);
            PG8_WAIT_V(8); PG8_WAIT_L(0); PG8_BAR; PG8_MMA(1, 0, At, B0); PG8_MMA(1, 1, At, B1); PG8_BAR; PG8_SCHED;
            PG8_LDB(B0, 1, 0); PG8_LDB(B1, 1, 1); PG8_SCHED; PG8_LDA(At, 1, 0); PG8_STAGE(PG8_SA(0, 1), a2 + hstep, voffA);
            PG8_WAIT_V(8); PG8_WAIT_L(0); PG8_BAR; PG8_MMA(0, 0, At, B0); PG8_MMA(0, 1, At, B1); PG8_BAR; PG8_SCHED;
            PG8_LDA(At, 1, 1); PG8_STAGE(PG8_SB(1, 0), b3, voffB); PG8_STAGE(PG8_SB(1, 1), b3 + hstep, voffB); PG8_STAGE(PG8_SA(1, 0), a3, voffA);
            PG8_WAIT_V(8); PG8_WAIT_L(0); PG8_BAR; PG8_MMA(1, 0, At, B0); PG8_MMA(1, 1, At, B1); PG8_BAR; PG8_SCHED;
            } else {
            PG8_LDB(B0, 0, 0); PG8_SCHED; PG8_LDA(At, 0, 0); PG8_STAGE(PG8_SA(1, 1), a1 + hstep, voffA);
            PG8_WAIT_L(8); PG8_BAR; PG8_WAIT_L(0); PG8_MMA(0, 0, At, B0); PG8_BAR; PG8_SCHED;
            PG8_LDB(B1, 0, 1); PG8_STAGE(PG8_SB(0, 0), b2, voffB);
            PG8_BAR; PG8_WAIT_L(0); PG8_MMA(0, 1, At, B1); PG8_BAR;
            PG8_LDA(At, 0, 1); PG8_STAGE(PG8_SA(0, 0), a2, voffA);
            PG8_BAR; PG8_WAIT_L(0); PG8_MMA(1, 0, At, B0); PG8_BAR; PG8_SCHED;
            PG8_STAGE(PG8_SB(0, 1), b2 + hstep, voffB);
            PG8_WAIT_V(6); PG8_BAR; PG8_MMA(1, 1, At, B1); PG8_BAR;
            PG8_LDB(B0, 1, 0); PG8_SCHED; PG8_LDA(At, 1, 0); PG8_STAGE(PG8_SA(0, 1), a2 + hstep, voffA);
            PG8_WAIT_L(8); PG8_BAR; PG8_WAIT_L(0); PG8_MMA(0, 0, At, B0); PG8_BAR; PG8_SCHED;
            PG8_LDB(B1, 1, 1); PG8_STAGE(PG8_SB(1, 0), b3, voffB);
            PG8_BAR; PG8_WAIT_L(0); PG8_MMA(0, 1, At, B1); PG8_BAR;
            PG8_LDA(At, 1, 1); PG8_STAGE(PG8_SA(1, 0), a3, voffA);
            PG8_BAR; PG8_WAIT_L(0); PG8_MMA(1, 0, At, B0); PG8_BAR; PG8_SCHED;
            PG8_STAGE(PG8_SB(1, 1), b3 + hstep, voffB);
            PG8_WAIT_V(6); PG8_BAR; PG8_MMA(1, 1, At, B1); PG8_BAR;
            }
        }
        if constexpr (ALIGN_EPI) { if (wr == 0) PG8_BAR; }
        if constexpr (!Epi::AFTER_DRAIN) { E(acc, cur, wr, wc, fr, fq); S.done(cur); }
        if (!has_next) break;
#pragma unroll
        for (int a = 0; a < 2; ++a)
#pragma unroll
            for (int b = 0; b < 2; ++b)
#pragma unroll
                for (int m = 0; m < 4; ++m)
#pragma unroll
                    for (int n = 0; n < 2; ++n) acc[a][b][m][n] = (f32x4){0.f, 0.f, 0.f, 0.f};
        cur = nxt; cA = nA; cB = nB; ++ui;
        if constexpr (ALIGN_EPI) { if (wr == 1) PG8_BAR; }
    }
    PG8_WAIT_V(0);
    if constexpr (!ALIGN_EPI) { if (wr == 0) PG8_BAR; }
    PG8_BAR;
    if constexpr (Epi::AFTER_DRAIN) { E.fused(acc, cur, wr, wc, fr, fq, lds, wid, lane); S.done(cur); }
#undef PG8_SA
#undef PG8_SB
#undef PG8_STAGE
#undef PG8_LDA
#undef PG8_LDB
#undef PG8_MMA
#undef PG8_WAIT_V
#undef PG8_WAIT_L
#undef PG8_BAR
#undef PG8_SCHED
}
}

#ifndef MK_N_LAUNCHES
#define MK_N_LAUNCHES 1
#endif

#define LAS __attribute__((address_space(3)))
typedef unsigned short bf16_t;
typedef unsigned u32x4 __attribute__((ext_vector_type(4)));
typedef unsigned u32x2 __attribute__((ext_vector_type(2)));
typedef float f32x4 __attribute__((ext_vector_type(4)));
typedef float f32x2 __attribute__((ext_vector_type(2)));
typedef short bf16x8 __attribute__((ext_vector_type(8)));

constexpr int D = 1024, NBATCH = 8, SEQL = 2048, CTXL = 256;
constexpr int RL = NBATCH * SEQL;
constexpr int RC = NBATCH * CTXL;
constexpr int RT = RL + RC;
constexpr int PIN = 2848, PINP = 3072, PALD = 1536, PRLD = 1280, FF = 4096;
constexpr float EPS = 1e-6f;
constexpr int NTHREADS = 512, NWAVES = 8;
constexpr int LDS_BYTES = 163840;
constexpr int LDS_BARST = LDS_BYTES - 16;
constexpr int NPHASES = 22;

constexpr size_t MiB = 1u << 20;
constexpr size_t WS_WT = 0;
constexpr size_t WT_LAYER = 24 * MiB, WT_OUT = 6 * MiB, WT_W1 = 8 * MiB, WT_W2 = 16 * MiB;
constexpr size_t WS_XN = 48 * MiB;
constexpr size_t WS_PA = 84 * MiB;
constexpr size_t WS_PR = 138 * MiB;
constexpr size_t WS_CV = 183 * MiB;
constexpr size_t WS_RAWB = 84 * MiB;
constexpr size_t WS_H = 84 * MiB;
constexpr size_t WS_CTXRES = 237 * MiB;
constexpr size_t WS_GATES = 245 * MiB;
constexpr size_t WS_MOD = 248 * MiB;
constexpr size_t WS_CTL = 249 * MiB;
constexpr size_t CTL_BYTES = 16384;
constexpr size_t WS_PART = WS_H;
constexpr size_t WS_END = 250 * MiB;

struct Params { const float* in[31]; float* out; unsigned char* ws; int lo, hi; };

enum { I_X = 0, I_C, I_CTX, I_CCTX, I_WADA, I_BADA, I_GMIX, I_WIN, I_CAW, I_CAB, I_BIG, I_BFG, I_GHA, I_CBW, I_CBB, I_DTB, I_ALOG, I_DSKIP, I_GNB,
       I_CCW, I_CCB, I_WRG, I_BRG, I_LAM, I_WOUT, I_GMLP, I_W1, I_B1, I_W2, I_B2, I_GFIN };

__device__ __forceinline__ unsigned f2bf(float f) { unsigned u = __builtin_bit_cast(unsigned, f); return (u + 0x7fffu + ((u >> 16) & 1u)) >> 16; }
typedef __bf16 bf16x2_t __attribute__((ext_vector_type(2)));
__device__ __forceinline__ unsigned pk2(float lo, float hi) { const f32x2 v = {lo, hi}; const bf16x2_t b = __builtin_convertvector(v, bf16x2_t); return __builtin_bit_cast(unsigned, b); }
__device__ __forceinline__ float bf_lo(unsigned u) { return __builtin_bit_cast(float, u << 16); }
__device__ __forceinline__ float bf_hi(unsigned u) { return __builtin_bit_cast(float, u & 0xffff0000u); }
__device__ __forceinline__ float bf1(unsigned short h) { return __builtin_bit_cast(float, ((unsigned)h) << 16); }
__device__ __forceinline__ float wave_sum(float v) {
#pragma unroll
    for (int o = 1; o < 64; o <<= 1) v += __shfl_xor(v, o);
    return v;
}
__device__ __forceinline__ float sigmoidf_(float x) { return __builtin_amdgcn_rcpf(1.f + __expf(-x)); }
__device__ __forceinline__ float siluf_(float x) { return x * __builtin_amdgcn_rcpf(1.f + __expf(-x)); }
__device__ __forceinline__ float softplusf_(float x) { return fmaxf(x, 0.f) + log1pf(__expf(-fabsf(x))); }
__device__ __forceinline__ float gelu_tanh(float x) { const float u = 0.7978845608028654f * (x + 0.044715f * x * x * x); const float e = __expf(2.f * u); const float th = 1.f - 2.f / (e + 1.f); return 0.5f * x * (1.f + th); }

__device__ __forceinline__ void st16_wt(void* ptr, u32x4 v) { asm volatile("global_store_dwordx4 %0, %1, off sc1\n\ts_nop 1" :: "v"(ptr), "v"(v) : "memory"); }
__device__ __forceinline__ void st16_wt(void* ptr, f32x4 v) { asm volatile("global_store_dwordx4 %0, %1, off sc1\n\ts_nop 1" :: "v"(ptr), "v"(v) : "memory"); }
__device__ __forceinline__ void st8_wt(void* ptr, u32x2 v) { __hip_atomic_store((unsigned long long*)ptr, __builtin_bit_cast(unsigned long long, v), __ATOMIC_RELAXED, __HIP_MEMORY_SCOPE_AGENT); }
__device__ __forceinline__ void st4_wt(float* ptr, float v) { __hip_atomic_store(ptr, v, __ATOMIC_RELAXED, __HIP_MEMORY_SCOPE_AGENT); }
#define LDS_BARRIER() asm volatile("s_waitcnt lgkmcnt(0)\n\ts_barrier" ::: "memory")
constexpr int LS = 72;
__device__ __forceinline__ f32x4 mma64(const LAS bf16_t* A, const LAS bf16_t* Bt, int lane, f32x4 acc) {
    const int r = lane & 15, q = lane >> 4;
#pragma unroll
    for (int kk = 0; kk < 2; ++kk) {
        const bf16x8 a = *(const LAS bf16x8*)(A + r * LS + kk * 32 + q * 8);
        const bf16x8 b = *(const LAS bf16x8*)(Bt + r * LS + kk * 32 + q * 8);
        acc = __builtin_amdgcn_mfma_f32_16x16x32_bf16(a, b, acc, 0, 0, 0);
    }
    return acc;
}

typedef short v4i16_t __attribute__((ext_vector_type(4)));
__device__ __forceinline__ bf16x8 tr_frag(const LAS bf16_t* T, int ld, int ctile, int kk, int lane) {
    const int g = lane >> 4, q = (lane & 15) >> 2, pp = lane & 3;
    const LAS bf16_t* a0 = T + (32 * kk + 8 * g + q) * ld + 16 * ctile + 4 * pp;
    const v4i16_t lo = __builtin_amdgcn_ds_read_tr16_b64_v4i16((LAS v4i16_t*)a0), hi = __builtin_amdgcn_ds_read_tr16_b64_v4i16((LAS v4i16_t*)(a0 + 4 * ld));
    return (bf16x8){lo.x, lo.y, lo.z, lo.w, hi.x, hi.y, hi.z, hi.w};
}
#define XB_TMO      128
#define XB_XCNT(j)  (256  + 64 * (j))
#define XB_XSUB(j)  (1280 + 64 * (j))
#define XB_XGEN(j)  (2304 + 64 * (j))
#define XB_TOP      3328
#define XB_TOPGEN   3392
#define XCD_BAR_WORDS 3456
#define XB_SPIN_CAP (1u << 18)

__device__ __forceinline__ unsigned xb_ld(unsigned* p)              { return __hip_atomic_load(p, __ATOMIC_RELAXED, __HIP_MEMORY_SCOPE_AGENT); }
__device__ __forceinline__ unsigned xb_add(unsigned* p, unsigned v) { return __hip_atomic_fetch_add(p, v, __ATOMIC_RELAXED, __HIP_MEMORY_SCOPE_AGENT); }
__device__ __forceinline__ unsigned xb_xcc_id() { return (unsigned)__builtin_amdgcn_s_getreg((3 << 11) | 20) & 0xFu; }
#define XB_SPIN(cond, bar) do { unsigned _sp = 0; while (cond) { __builtin_amdgcn_s_sleep(1); \
    if ((++_sp & 255u) == 0u) { if (xb_ld(&(bar)[XB_TMO])) break; if (_sp > XB_SPIN_CAP) { atomicAdd(&(bar)[XB_TMO], 1u); break; } } } } while (0)

struct XcdBarrier {
    unsigned* bar; unsigned x;
    volatile LAS unsigned* st;
};

__device__ __forceinline__ XcdBarrier xcd_barrier_post(unsigned* bar, volatile LAS unsigned* st) {
    XcdBarrier b; b.bar = bar; b.x = xb_xcc_id(); b.st = st;
    if (threadIdx.x == 0) (void)xb_add(&bar[XB_XCNT(b.x)], 1u);
    return b;
}
__device__ __forceinline__ void xcd_barrier_complete(unsigned* bar, unsigned x, unsigned& nloc, unsigned& nx) {
    const unsigned G = gridDim.x * gridDim.y * gridDim.z;
    unsigned sum, cnt, mine, sp = 0u;
    for (;;) {
        sum = 0u; cnt = 0u; mine = 0u;
#pragma unroll
        for (unsigned j = 0; j < 16; ++j) { const unsigned c = xb_ld(&bar[XB_XCNT(j)]); sum += c; cnt += (c > 0u) ? 1u : 0u; mine = (j == x) ? c : mine; }
        if (sum == G) break;
        __builtin_amdgcn_s_sleep(1);
        if ((++sp & 255u) == 0u) { if (xb_ld(&bar[XB_TMO])) break; if (sp > XB_SPIN_CAP) { atomicAdd(&bar[XB_TMO], 1u); break; } }
    }
    nloc = mine > 0u ? mine : 1u; nx = cnt > 0u ? cnt : 1u;
}

__device__ __forceinline__ void xcd_barrier(const XcdBarrier& b) {
    asm volatile("s_waitcnt vmcnt(0)" ::: "memory");
    __syncthreads();
    if (threadIdx.x == 0) {
        unsigned* bar = b.bar;
        __builtin_amdgcn_s_waitcnt(0);
        unsigned nloc = b.st[0], nx = b.st[1];
        if (nloc == 0u) { xcd_barrier_complete(bar, b.x, nloc, nx); b.st[0] = nloc; b.st[1] = nx; }
        const unsigned old = xb_add(&bar[XB_XSUB(b.x)], 1u);
        const unsigned gen = old / nloc;
        if (old + 1u == (gen + 1u) * nloc) {
            asm volatile("s_waitcnt vmcnt(0)" ::: "memory");
            const unsigned og = xb_add(&bar[XB_TOP], 1u);
            const unsigned tg = og / nx;
            if (og + 1u == (tg + 1u) * nx) xb_add(&bar[XB_TOPGEN], 1u);
            else XB_SPIN(xb_ld(&bar[XB_TOPGEN]) == tg, bar);
            __builtin_amdgcn_fence(__ATOMIC_ACQUIRE, "agent");
            xb_add(&bar[XB_XGEN(b.x)], 1u);
            asm volatile("s_waitcnt vmcnt(0)" ::: "memory");
        } else {
            XB_SPIN(xb_ld(&bar[XB_XGEN(b.x)]) == gen, bar);
            __builtin_amdgcn_fence(__ATOMIC_ACQUIRE, "agent");
            asm volatile("s_waitcnt vmcnt(0)" ::: "memory");
        }
    }
    __syncthreads();
}

struct EpiAll {
    static constexpr bool PERM = true, AFTER_DRAIN = false;
    const Params* pp; int kind, l;
    __device__ __forceinline__ void operator()(const pg8::f32x4 (&acc)[2][2][4][2], const pg8::Unit& u, int wr, int wc, int fr, int fq) const {
        const Params& p = *pp;
        if (kind == 0) {
            const int row0 = u.pm * 256 + wr * 64 + fr;
            if (u.pn < 11) {
                const bool pa = u.pn < 6; const int ld = pa ? PALD : PRLD;
                bf16_t* P = (bf16_t*)(p.ws + (pa ? WS_PA : WS_PR));
                const int col0 = (pa ? u.pn : u.pn - 6) * 256 + wc * 32 + 8 * fq;
#pragma unroll
                for (int ai = 0; ai < 2; ++ai)
#pragma unroll
                    for (int m = 0; m < 4; ++m) { bf16_t* rowp = P + (size_t)(row0 + ai * 128 + m * 16) * ld + col0;
#pragma unroll
                        for (int bj = 0; bj < 2; ++bj) { const pg8::f32x4 v0 = acc[ai][bj][m][0], v1 = acc[ai][bj][m][1];
                            u32x4 w; w.x = pg8::cvt_pk_bf16(v0[0], v0[1]); w.y = pg8::cvt_pk_bf16(v0[2], v0[3]); w.z = pg8::cvt_pk_bf16(v1[0], v1[1]); w.w = pg8::cvt_pk_bf16(v1[2], v1[3]);
                            st16_wt(rowp + bj * 128, w); } }
            } else if (wc == 0) {
                float* gates = (float*)(p.ws + WS_GATES);
#pragma unroll
                for (int ai = 0; ai < 2; ++ai)
#pragma unroll
                    for (int m = 0; m < 4; ++m) { float* gp = gates + (size_t)(row0 + ai * 128 + m * 16) * 32 + 8 * fq;
                        st16_wt(gp, acc[ai][0][m][0]); st16_wt(gp + 4, acc[ai][0][m][1]); }
            }
        } else if (kind == 4) {
            bf16_t* part = (bf16_t*)(p.ws + WS_PART) + (size_t)u.ks * RC * D;
            const int row0 = u.pm * 256 + wr * 64 + fr; const int col0 = u.pn * 256 + wc * 32 + 8 * fq;
#pragma unroll
            for (int bj = 0; bj < 2; ++bj)
#pragma unroll
                for (int ai = 0; ai < 2; ++ai)
#pragma unroll
                    for (int m = 0; m < 4; ++m) { const pg8::f32x4 v0 = acc[ai][bj][m][0], v1 = acc[ai][bj][m][1];
                        u32x4 w; w.x = pk2(v0[0], v0[1]); w.y = pk2(v0[2], v0[3]); w.z = pk2(v1[0], v1[1]); w.w = pk2(v1[2], v1[3]);
                        st16_wt(part + (size_t)(row0 + ai * 128 + m * 16) * D + col0 + bj * 128, w); }
        } else if (kind == 2) {
            bf16_t* H = (bf16_t*)(p.ws + WS_H); const float* b1 = p.in[I_B1] + l * FF;
            const int row0 = u.pm * 256 + wr * 64 + fr; const int col0 = u.pn * 256 + wc * 32 + 8 * fq;
#pragma unroll
            for (int bj = 0; bj < 2; ++bj) { const int c = col0 + bj * 128;
                const f32x4 b0 = *(const f32x4*)(b1 + c), bb1 = *(const f32x4*)(b1 + c + 4);
#pragma unroll
                for (int ai = 0; ai < 2; ++ai)
#pragma unroll
                    for (int m = 0; m < 4; ++m) { f32x4 v0 = acc[ai][bj][m][0] + b0, v1 = acc[ai][bj][m][1] + bb1;
#pragma unroll
                        for (int i = 0; i < 4; ++i) { const float a = fmaxf(v0[i], 0.f), b = fmaxf(v1[i], 0.f); v0[i] = a * a; v1[i] = b * b; }
                        u32x4 w; w.x = pg8::cvt_pk_bf16(v0[0], v0[1]); w.y = pg8::cvt_pk_bf16(v0[2], v0[3]); w.z = pg8::cvt_pk_bf16(v1[0], v1[1]); w.w = pg8::cvt_pk_bf16(v1[2], v1[3]);
                        st16_wt(H + (size_t)(row0 + ai * 128 + m * 16) * FF + c, w); } }
        } else {
            const bool lat = u.pm < 64; const int bsel = lat ? (u.pm >> 3) : 8;
            const float* gate = (const float*)(p.ws + WS_MOD) + (size_t)(l * 9 + bsel) * 6144 + (kind == 1 ? 2 : 5) * 1024;
            const float* bias = p.in[I_B2] + l * D;
            const float bsc = kind == 3 ? 1.f : 0.f;
            const int rloc = (lat ? u.pm : u.pm - 64) * 256 + wr * 64 + fr;
            bf16_t* rs = lat ? (bf16_t*)p.out : (bf16_t*)(p.ws + WS_CTXRES);
            const bool f32src = (kind == 1 && l == 0);
            const float* ipf = (lat ? p.in[I_X] : p.in[I_CTX]) + (size_t)rloc * D;
            const bf16_t* ipb = rs + (size_t)rloc * D;
            bf16_t* op = ((kind == 3 && l == 1) ? (bf16_t*)(p.ws + WS_XN) : rs) + (size_t)rloc * D;
            const int col0 = u.pn * 256 + wc * 32 + 8 * fq;
#pragma unroll
            for (int bj = 0; bj < 2; ++bj) { const int c = col0 + bj * 128;
                const f32x4 g0 = *(const f32x4*)(gate + c), g1 = *(const f32x4*)(gate + c + 4);
                const f32x4 b0 = *(const f32x4*)(bias + c) * bsc, b1 = *(const f32x4*)(bias + c + 4) * bsc;
#pragma unroll
                for (int ai = 0; ai < 2; ++ai)
#pragma unroll
                    for (int m = 0; m < 4; ++m) { const size_t ro = (size_t)(ai * 128 + m * 16) * D + c;
                        f32x4 x0, x1;
                        if (f32src) { x0 = *(const f32x4*)(ipf + ro); x1 = *(const f32x4*)(ipf + ro + 4); }
                        else { const u32x4 xb = *(const u32x4*)(ipb + ro); x0 = (f32x4){bf_lo(xb.x), bf_hi(xb.x), bf_lo(xb.y), bf_hi(xb.y)}; x1 = (f32x4){bf_lo(xb.z), bf_hi(xb.z), bf_lo(xb.w), bf_hi(xb.w)}; }
                        const f32x4 y0 = x0 + g0 * (acc[ai][bj][m][0] + b0), y1 = x1 + g1 * (acc[ai][bj][m][1] + b1);
                        u32x4 w; w.x = pk2(y0[0], y0[1]); w.y = pk2(y0[2], y0[3]); w.z = pk2(y1[0], y1[1]); w.w = pk2(y1[2], y1[3]);
                        st16_wt(op + ro, w); } }
        }
    }
};

struct Order {
    pg8::StaticOrder so; int nslice;
    __device__ __forceinline__ bool next(int i, pg8::Unit& u) const {
        if (nslice == 0) return so.next(i, u);
        const int Lx = i * so.G + so.c; if (Lx >= nslice * 32) return false;
        u.ks = Lx >> 5; const int t = Lx & 31; u.pm = t >> 2; u.pn = t & 3; return true;
    }
    __device__ __forceinline__ void a_ready(const pg8::Unit&) const {}
    __device__ __forceinline__ void done(const pg8::Unit&) const {}
};
__device__ __forceinline__ int inproj_dest(int n) {
    if (n < 512) return n;
    if (n < 1024) return 1536 + (n - 512);
    if (n < 1040) return 2816 + (n - 1024);
    if (n < 1552) return 2048 + (n - 1040);
    if (n < 2064) return 512 + (n - 1552);
    if (n < 2320) return 1024 + (n - 2064);
    if (n < 2336) return 2832 + (n - 2320);
    if (n < 2592) return 1280 + (n - 2336);
    return 2560 + (n - 2592);
}
template <bool INMAP>
__device__ __forceinline__ void transpose_item(const float* W, int K, int N, bf16_t* WT, LAS float* scr, int item, int lane) {
    const int nblk = N / 32, kb = item / nblk, nb = item % nblk, k0 = 64 * kb, n0 = 32 * nb;
#pragma unroll 8
    for (int i = 0; i < 32; ++i) { const int kk = 2 * i + (lane >> 5); scr[kk * 33 + (lane & 31)] = W[(size_t)(k0 + kk) * N + n0 + (lane & 31)]; }
    asm volatile("s_waitcnt lgkmcnt(0)" ::: "memory");
    const int c = lane & 7;
#pragma unroll
    for (int j = 0; j < 4; ++j) { const int n = (lane >> 3) + 8 * j; const LAS float* s = scr + (8 * c) * 33 + n;
        u32x4 o; o.x = pk2(s[0 * 33], s[1 * 33]); o.y = pk2(s[2 * 33], s[3 * 33]); o.z = pk2(s[4 * 33], s[5 * 33]); o.w = pk2(s[6 * 33], s[7 * 33]);
        const int row = INMAP ? inproj_dest(n0 + n) : (n0 + n);
        st16_wt(WT + (size_t)row * K + k0 + 8 * c, o); }
    asm volatile("s_waitcnt lgkmcnt(0)" ::: "memory");
}
__device__ __forceinline__ void phase0(const Params& p, LAS unsigned char* L) {
    const int tid = tid_opaque(), lane = tid & 63, wave = tid >> 6;
    LAS float* sS = (LAS float*)L;
    LAS float* red = (LAS float*)(L + 36864);
    for (int i = tid; i < 9 * 1024; i += NTHREADS) { const int v = i >> 10, k = i & 1023; const float x = v < 8 ? p.in[I_C][v * 1024 + k] : p.in[I_CCTX][k]; sS[i] = siluf_(x); }
    __syncthreads();
    float* mod = (float*)(p.ws + WS_MOD);
    for (int unit = blockIdx.x; unit < 192; unit += gridDim.x) {
        const int l = unit / 96, nb = (unit % 96) * 64;
        const float* W = p.in[I_WADA] + (size_t)l * 1024 * 6144 + nb + lane;
        float acc[9];
#pragma unroll
        for (int v = 0; v < 9; ++v) acc[v] = 0.f;
#pragma unroll 8
        for (int k = wave * 128; k < wave * 128 + 128; k += 4) {
            const float w0 = W[(size_t)k * 6144], w1 = W[(size_t)(k + 1) * 6144], w2 = W[(size_t)(k + 2) * 6144], w3 = W[(size_t)(k + 3) * 6144];
#pragma unroll
            for (int v = 0; v < 9; ++v) { const f32x4 s4 = *(const LAS f32x4*)(sS + v * 1024 + k); acc[v] += (s4.x * w0 + s4.y * w1) + (s4.z * w2 + s4.w * w3); } }
#pragma unroll
        for (int v = 0; v < 9; ++v) red[(wave * 9 + v) * 64 + lane] = acc[v];
        __syncthreads();
        for (int i = tid; i < 576; i += NTHREADS) { const int v = i >> 6, ln = i & 63; float s = 0.f;
#pragma unroll
            for (int w = 0; w < 8; ++w) s += red[(w * 9 + v) * 64 + ln];
            st4_wt(mod + (size_t)(l * 9 + v) * 6144 + nb + ln, s + p.in[I_BADA][l * 6144 + nb + ln]); }
        __syncthreads();
    }
    __syncthreads();
    LAS float* scr = (LAS float*)(L + wave * 16384);
    const int gw = blockIdx.x * NWAVES + wave, NGW = gridDim.x * NWAVES;
    constexpr int I_IN = 16 * 89, I_OUT = 16 * 32, I_M1 = 16 * 128, I_M2 = 64 * 32, I_LAYER = I_IN + I_OUT + I_M1 + I_M2;
    const bool bal = (gridDim.x == 256); const int bx = blockIdx.x;
    const int nmine = !bal ? (2 * I_LAYER + NGW - 1) / NGW : (bx >= 192 ? 11 : (bx < 36 ? 5 : 4));
    for (int j = 0; j < nmine; ++j) {
        int it;
        if (!bal) it = gw + j * NGW;
        else if (bx >= 192) it = (bx - 192) * 88 + wave * 11 + j;
        else it = j < 4 ? 5632 + bx * 32 + wave * 4 + j : 11776 + bx * 8 + wave;
        if (it >= 2 * I_LAYER) continue;
        const int l = it / I_LAYER; int r = it % I_LAYER;
        bf16_t* wt = (bf16_t*)(p.ws + WS_WT + (size_t)l * WT_LAYER);
        if (r < I_IN) { transpose_item<true>(p.in[I_WIN] + (size_t)l * 1024 * PIN, 1024, PIN, wt, scr, r, lane); continue; } r -= I_IN;
        if (r < I_OUT) { transpose_item<false>(p.in[I_WOUT] + (size_t)l * 1024 * 1024, 1024, 1024, (bf16_t*)((unsigned char*)wt + WT_OUT), scr, r, lane); continue; } r -= I_OUT;
        if (r < I_M1) { transpose_item<false>(p.in[I_W1] + (size_t)l * 1024 * FF, 1024, FF, (bf16_t*)((unsigned char*)wt + WT_W1), scr, r, lane); continue; } r -= I_M1;
        transpose_item<false>(p.in[I_W2] + (size_t)l * FF * 1024, FF, 1024, (bf16_t*)((unsigned char*)wt + WT_W2), scr, r, lane);
    }
}

__device__ __forceinline__ void normmod_phase(const Params& p, int l, int which) {
    const bool first = (which == 0 && l == 0);
    const float* xlat = p.in[I_X]; const float* xctx = p.in[I_CTX];
    const bf16_t* rlat = (const bf16_t*)p.out; const bf16_t* rctx = (const bf16_t*)(p.ws + WS_CTXRES);
    const int nrows = (l == 1 && which == 1) ? RL : RT;
    const float* g = (which == 0 ? p.in[I_GMIX] : p.in[I_GMLP]) + l * D; const float* modl = (const float*)(p.ws + WS_MOD) + (size_t)l * 9 * 6144;
    const int shi = which == 0 ? 0 : 3, sci = shi + 1;
    const int tid = tid_opaque(), lane = tid & 63, wave = tid >> 6;
    const int gw = blockIdx.x * NWAVES + wave, NGW = gridDim.x * NWAVES;
    bf16_t* XN = (bf16_t*)(p.ws + WS_XN);
    for (int row = gw; row < nrows; row += NGW) {
        const bool lat = row < RL; const int bsel = lat ? (row >> 11) : 8;
        const float* xr = lat ? xlat + (size_t)row * D : xctx + (size_t)(row - RL) * D;
        const bf16_t* xb = lat ? rlat + (size_t)row * D : rctx + (size_t)(row - RL) * D;
        const float* sh = modl + bsel * 6144 + shi * 1024; const float* sc = modl + bsel * 6144 + sci * 1024;
        f32x4 v[4]; float s = 0.f;
        const bool fold = (which == 0 && l == 1 && !lat);
#pragma unroll
        for (int j = 0; j < 4; ++j) { const int cj = 8 * lane + 512 * (j >> 1) + 4 * (j & 1);
            if (first) v[j] = *(const f32x4*)(xr + cj); else { const u32x2 t = *(const u32x2*)(xb + cj); v[j] = (f32x4){bf_lo(t.x), bf_hi(t.x), bf_lo(t.y), bf_hi(t.y)}; }
            if (fold) { const bf16_t* pt = (const bf16_t*)(p.ws + WS_PART) + (size_t)(row - RL) * D + cj;
                f32x4 a = *(const f32x4*)(p.in[I_B2] + cj);
#pragma unroll
                for (int ks = 0; ks < 4; ++ks) { const u32x2 t = *(const u32x2*)(pt + (size_t)ks * RC * D); a = a + (f32x4){bf_lo(t.x), bf_hi(t.x), bf_lo(t.y), bf_hi(t.y)}; }
                v[j] = v[j] + *(const f32x4*)((const float*)(p.ws + WS_MOD) + 8 * 6144 + 5 * 1024 + cj) * a; } s += (v[j].x * v[j].x + v[j].y * v[j].y) + (v[j].z * v[j].z + v[j].w * v[j].w); }
        const float rs = rsqrtf(wave_sum(s) * (1.f / D) + EPS);
#pragma unroll
        for (int h = 0; h < 2; ++h) { const int c = 8 * lane + 512 * h;
            const f32x4 g0 = *(const f32x4*)(g + c), g1 = *(const f32x4*)(g + c + 4), s0 = *(const f32x4*)(sh + c), s1 = *(const f32x4*)(sh + c + 4), c0 = *(const f32x4*)(sc + c), c1 = *(const f32x4*)(sc + c + 4);
            const f32x4 o0 = v[2 * h] * rs * g0 * (c0 + 1.f) + s0, o1 = v[2 * h + 1] * rs * g1 * (c1 + 1.f) + s1;
            u32x4 w; w.x = pk2(o0.x, o0.y); w.y = pk2(o0.z, o0.w); w.z = pk2(o1.x, o1.y); w.w = pk2(o1.z, o1.w);
            st16_wt(XN + (size_t)row * D + c, w); }
    }
}
__device__ __forceinline__ void final_phase(const Params& p) {
    const int tid = tid_opaque(), lane = tid & 63, wave = tid >> 6;
    const int gw = blockIdx.x * NWAVES + wave, NGW = gridDim.x * NWAVES;
    const float* g = p.in[I_GFIN]; const bf16_t* X = (const bf16_t*)(p.ws + WS_XN);
    for (int row = gw; row < RL; row += NGW) {
        const bf16_t* xb = X + (size_t)row * D; float* xr = p.out + (size_t)row * D;
        f32x4 v[4]; float s = 0.f;
#pragma unroll
        for (int j = 0; j < 4; ++j) { const u32x2 t = *(const u32x2*)(xb + 4 * lane + 256 * j); v[j] = (f32x4){bf_lo(t.x), bf_hi(t.x), bf_lo(t.y), bf_hi(t.y)}; s += (v[j].x * v[j].x + v[j].y * v[j].y) + (v[j].z * v[j].z + v[j].w * v[j].w); }
        const float rs = rsqrtf(wave_sum(s) * (1.f / D) + EPS);
#pragma unroll
        for (int j = 0; j < 4; ++j) { const int c = 4 * lane + 256 * j; const f32x4 gg = *(const f32x4*)(g + c); *(f32x4*)(xr + c) = v[j] * rs * gg; }
    }
}
__device__ __forceinline__ void finalize_phase(const Params& p, int l, int nrows) {
    const int tid = tid_opaque(), lane = tid & 63, wave = tid >> 6;
    const int gw = blockIdx.x * NWAVES + wave, NGW = gridDim.x * NWAVES;
    bf16_t* RF = (bf16_t*)(p.ws + WS_XN); const bf16_t* RB = (const bf16_t*)(p.ws + WS_RAWB); const bf16_t* P = (const bf16_t*)(p.ws + WS_PR);
    const float* gha = p.in[I_GHA] + l * 256; const float* gnb = p.in[I_GNB] + l * 512;
    for (int row = gw; row < nrows; row += NGW) {
        bf16_t* rf = RF + (size_t)row * D + 4 * lane; const bf16_t* rb = RB + (size_t)row * D + 4 * lane; const bf16_t* pr = P + (size_t)row * PRLD + 4 * lane;
        float v[4][4];
#pragma unroll
        for (int sgi = 0; sgi < 4; ++sgi) { const u32x2 a = *(const u32x2*)(rf + sgi * 256), b = *(const u32x2*)(rb + sgi * 256);
            v[sgi][0] = bf_lo(a.x) + bf_lo(b.x); v[sgi][1] = bf_hi(a.x) + bf_hi(b.x); v[sgi][2] = bf_lo(a.y) + bf_lo(b.y); v[sgi][3] = bf_hi(a.y) + bf_hi(b.y); }
        const u32x2 ov = *(const u32x2*)(pr + 256), z0 = *(const u32x2*)(pr + 512), z1 = *(const u32x2*)(pr + 768), gv = *(const u32x2*)(pr + 1024);
        { float s = v[0][0] * v[0][0] + v[0][1] * v[0][1] + v[0][2] * v[0][2] + v[0][3] * v[0][3];
#pragma unroll
          for (int o = 1; o < 16; o <<= 1) s += __shfl_xor(s, o);
          const float rs = rsqrtf(s * (1.f / 64.f) + EPS); const f32x4 gg = *(const f32x4*)(gha + 4 * lane);
          v[0][0] = v[0][0] * rs * gg.x * sigmoidf_(bf_lo(ov.x)); v[0][1] = v[0][1] * rs * gg.y * sigmoidf_(bf_hi(ov.x));
          v[0][2] = v[0][2] * rs * gg.z * sigmoidf_(bf_lo(ov.y)); v[0][3] = v[0][3] * rs * gg.w * sigmoidf_(bf_hi(ov.y)); }
        { v[1][0] *= siluf_(bf_lo(z0.x)); v[1][1] *= siluf_(bf_hi(z0.x)); v[1][2] *= siluf_(bf_lo(z0.y)); v[1][3] *= siluf_(bf_hi(z0.y));
          v[2][0] *= siluf_(bf_lo(z1.x)); v[2][1] *= siluf_(bf_hi(z1.x)); v[2][2] *= siluf_(bf_lo(z1.y)); v[2][3] *= siluf_(bf_hi(z1.y));
          float s = 0.f;
#pragma unroll
          for (int i = 0; i < 4; ++i) s += v[1][i] * v[1][i] + v[2][i] * v[2][i];
          const float rs = rsqrtf(wave_sum(s) * (1.f / 512.f) + EPS);
          const f32x4 g0 = *(const f32x4*)(gnb + 4 * lane), g1 = *(const f32x4*)(gnb + 256 + 4 * lane);
#pragma unroll
          for (int i = 0; i < 4; ++i) { v[1][i] = v[1][i] * rs * g0[i]; v[2][i] = v[2][i] * rs * g1[i]; } }
        { v[3][0] *= gelu_tanh(bf_lo(gv.x)); v[3][1] *= gelu_tanh(bf_hi(gv.x)); v[3][2] *= gelu_tanh(bf_lo(gv.y)); v[3][3] *= gelu_tanh(bf_hi(gv.y)); }
#pragma unroll
        for (int sgi = 0; sgi < 4; ++sgi) { u32x2 w; w.x = pk2(v[sgi][0], v[sgi][1]); w.y = pk2(v[sgi][2], v[sgi][3]); st8_wt(rf + sgi * 256, w); }
    }
}

__device__ __forceinline__ void conv_phase(const Params& p, LAS unsigned char* L, int l) {
    const int tid = tid_opaque();
    if (tid >= 384) return;
    const int stream = tid >= 192 ? 1 : 0, cgp = tid - 192 * stream, c0 = cgp * 8;
    float w[5][8];
#pragma unroll
    for (int j = 0; j < 5; ++j)
#pragma unroll
        for (int i = 0; i < 8; ++i) { const int c = c0 + i; float v;
            if (c0 < 512) v = j < 4 ? p.in[I_CAW][(l * 4 + j) * 512 + c] : p.in[I_CAB][l * 512 + c];
            else if (c0 < 1280) v = j < 4 ? p.in[I_CBW][(l * 4 + j) * 768 + (c - 512)] : p.in[I_CBB][l * 768 + (c - 512)];
            else v = j < 4 ? p.in[I_CCW][(l * 4 + j) * 256 + (c - 1280)] : p.in[I_CCB][l * 256 + (c - 1280)];
            w[j][i] = v; }
    const bf16_t* PA = (const bf16_t*)(p.ws + WS_PA); bf16_t* CV = (bf16_t*)(p.ws + WS_CV);
    const bool act = c0 < 1280; const float qs = c0 < 256 ? 0.125f : 1.f;
    for (int it = blockIdx.x; it < 2304; it += gridDim.x) {
        const int seg = 2 * it + stream;
        const bool lat = seg < 4096; const int sb = lat ? seg : seg - 4096;
        const int bb = lat ? (sb >> 9) : (sb >> 6), pf0 = (lat ? (sb & 511) : (sb & 63)) * 4;
        const int Lseg = lat ? SEQL : CTXL, base = lat ? bb * SEQL : RL + bb * CTXL;
        const bool cm = lat && !act;
        u32x4 x[7];
#pragma unroll
        for (int r = 0; r < 7; ++r) { const int pj = pf0 + r - 2; const bool ok = (pj >= 0) && (pj < Lseg); const int pq = ok ? pj : pf0;
            const int tj = cm ? ((pq & 31) * 64 + (pq >> 5)) : pq;
            x[r] = *(const u32x4*)(PA + (size_t)(base + tj) * PALD + c0); if (!ok) x[r] = (u32x4){0u, 0u, 0u, 0u}; }
#pragma unroll
        for (int o = 0; o < 4; ++o) {
            float v[8];
#pragma unroll
            for (int i = 0; i < 8; ++i) v[i] = w[4][i];
#pragma unroll
            for (int j = 0; j < 4; ++j) { const u32x4 x_ = x[o + j];
                v[0] += w[j][0] * bf_lo(x_.x); v[1] += w[j][1] * bf_hi(x_.x); v[2] += w[j][2] * bf_lo(x_.y); v[3] += w[j][3] * bf_hi(x_.y);
                v[4] += w[j][4] * bf_lo(x_.z); v[5] += w[j][5] * bf_hi(x_.z); v[6] += w[j][6] * bf_lo(x_.w); v[7] += w[j][7] * bf_hi(x_.w); }
            if (act) {
#pragma unroll
                for (int i = 0; i < 8; ++i) v[i] = siluf_(v[i]) * qs;
            }
            const int pq = pf0 + o; const int tj = cm ? ((pq & 31) * 64 + (pq >> 5)) : pq;
            u32x4 wv; wv.x = pk2(v[0], v[1]); wv.y = pk2(v[2], v[3]); wv.z = pk2(v[4], v[5]); wv.w = pk2(v[6], v[7]);
            st16_wt(CV + (size_t)(base + tj) * PALD + c0, wv);
        }
    }
}

template <int MODE>
__device__ __forceinline__ void seq_unit(const Params& p, LAS unsigned char* L, int l, int b, int hd, int d) {
    const int tid = tid_opaque(), lane = tid & 63, wave = __builtin_amdgcn_readfirstlane(tid >> 6);
    const int r16 = lane & 15, q4 = lane >> 4;
    const int wpar = wave & 1, w8 = (wave >> 1) * 16;
    constexpr int OB = 40960, LSV = 88;
    LAS bf16_t* sS = (LAS bf16_t*)(L + 81920); LAS bf16_t* sC = (LAS bf16_t*)(L + 91136);
    LAS float* tabG = (LAS float*)(L + 114176); LAS float* tabM = (LAS float*)(L + 123392); LAS float* tabB = (LAS float*)(L + 132608);
    LAS bf16_t* sO = (LAS bf16_t*)(L + 142336);
    LAS float* rden = (LAS float*)(L + 141824);
    const bf16_t* CV = (const bf16_t*)(p.ws + WS_CV);
    const float* G = (const float*)(p.ws + WS_GATES);
    bf16_t* outp = (bf16_t*)(p.ws + (d ? WS_RAWB : WS_XN));
    const bf16_t* P2; int ld2;
    int col0, col1, col2, ocol, gc0, gc1 = 0; float gb0, gb1 = 0.f, Aneg = 0.f, dskip = 0.f;
    if (MODE == 0) { col0 = hd * 64; col1 = 256 + hd * 64; col2 = hd * 64; P2 = (const bf16_t*)(p.ws + WS_PR); ld2 = PRLD; ocol = hd * 64; gc0 = d * 4 + hd; gc1 = 8 + d * 4 + hd;
        gb0 = p.in[I_BIG][(l * 2 + d) * 4 + hd]; gb1 = p.in[I_BFG][(l * 2 + d) * 4 + hd]; }
    else { const int g = hd >> 2; col0 = 1152 + g * 64; col1 = 1024 + g * 64; col2 = 512 + hd * 64; P2 = CV; ld2 = PALD; ocol = 256 + hd * 64; gc0 = 16 + d * 8 + hd;
        gb0 = p.in[I_DTB][(l * 2 + d) * 8 + hd]; Aneg = -__expf(p.in[I_ALOG][(l * 2 + d) * 8 + hd]); dskip = p.in[I_DSKIP][l * 8 + hd]; }
    __syncthreads();
    for (int i = tid; i < 80 * LS / 2; i += NTHREADS) ((LAS unsigned*)sC)[i] = 0u;
    if (MODE == 0 && tid < 128) { LAS unsigned char* ob = L + (tid >> 6) * OB; const int row = tid & 63;
        unsigned z_ = 0u, o_ = 0x00003F80u; asm volatile("" : "+v"(z_), "+v"(o_));
        const u32x4 zz_ = {z_, z_, z_, z_}, oo_ = {o_, z_, z_, z_};
        *(LAS u32x4*)(ob + 18432 + (row * LSV + 64) * 2) = oo_; *(LAS u32x4*)(ob + 18432 + (row * LSV + 72) * 2) = zz_;
        *(LAS u32x4*)(ob + 29696 + (row * LSV + 64) * 2) = zz_; *(LAS u32x4*)(ob + 29696 + (row * LSV + 72) * 2) = zz_; }
    for (int c = wave; c < 36; c += 8) {
        const bool isctx = c < 4; const int cc = isctx ? c : c - 4; const int Lseg = isctx ? CTXL : SEQL; const int base = isctx ? RL + b * CTXL : b * SEQL;
        const int pos0 = cc * 64 + lane; const int tau0 = d ? Lseg - 1 - pos0 : pos0; const float* gp = G + (size_t)(base + tau0) * 32;
        if (MODE == 0) {
            const float ig = gp[gc0] + gb0, fg = gp[gc1] + gb1;
            const float lf = fminf(fg, 0.f) - log1pf(__expf(-fabsf(fg)));
            float bs = lf;
#pragma unroll
            for (int o = 1; o < 64; o <<= 1) { const float t = __shfl_up(bs, o); if (lane >= o) bs += t; }
            const float g = ig - bs; float M = g;
#pragma unroll
            for (int o = 1; o < 64; o <<= 1) { const float t = __shfl_up(M, o); if (lane >= o) M = fmaxf(M, t); }
            tabG[c * 64 + lane] = g; tabM[c * 64 + lane] = M; tabB[c * 64 + lane] = bs;
        } else {
            const float dtv = softplusf_(gp[gc0] + gb0);
            float cs = dtv * Aneg;
#pragma unroll
            for (int o = 1; o < 64; o <<= 1) { const float t = __shfl_up(cs, o); if (lane >= o) cs += t; }
            tabG[c * 64 + lane] = cs; tabM[c * 64 + lane] = dtv;
        }
    }
    f32x4 st[2] = {{0.f, 0.f, 0.f, 0.f}, {0.f, 0.f, 0.f, 0.f}};
    f32x4 stx = {0.f, 0.f, 0.f, 0.f};
    f32x4 res[2] = {{0.f, 0.f, 0.f, 0.f}, {0.f, 0.f, 0.f, 0.f}};
    float m_in = 0.f;
    u32x4 r0, r1, r2, r3, r4, r5;
#define PREFETCH(CN) do { const int cn_ = (CN); const bool isctx_ = cn_ < 4; const int cc_ = isctx_ ? cn_ : cn_ - 4; const int Lseg_ = isctx_ ? CTXL : SEQL; const int base_ = isctx_ ? RL + b * CTXL : b * SEQL; \
        const int pos_ = cc_ * 64 + lane; const int row_ = base_ + (d ? Lseg_ - 1 - pos_ : pos_); \
        r0 = *(const u32x4*)(CV + (size_t)row_ * PALD + col0 + w8); r1 = *(const u32x4*)(CV + (size_t)row_ * PALD + col1 + w8); r2 = *(const u32x4*)(P2 + (size_t)row_ * ld2 + col2 + w8); \
        r3 = *(const u32x4*)(CV + (size_t)row_ * PALD + col0 + w8 + 8); r4 = *(const u32x4*)(CV + (size_t)row_ * PALD + col1 + w8 + 8); r5 = *(const u32x4*)(P2 + (size_t)row_ * ld2 + col2 + w8 + 8); } while (0)
#define WRITEOUT(CP) do { const int cp_ = (CP); const bool isctx_ = cp_ < 4; const int cc_ = isctx_ ? cp_ : cp_ - 4; const int Lseg_ = isctx_ ? CTXL : SEQL; const int base_ = isctx_ ? RL + b * CTXL : b * SEQL; \
        const int tok_ = tid >> 3, grp_ = (tid & 7) * 8; const int pos_ = cc_ * 64 + tok_; const int row_ = base_ + (d ? Lseg_ - 1 - pos_ : pos_); \
        st16_wt(outp + (size_t)row_ * D + ocol + grp_, *(const LAS u32x4*)(sO + tok_ * LS + grp_)); } while (0)
    r0 = r1 = r2 = r3 = r4 = r5 = (u32x4){0u, 0u, 0u, 0u};
    if (wpar == 0) PREFETCH(0); else PREFETCH(1);
    __syncthreads();
    for (int c = -1; c < 36; ++c) {
        const int cur = c & 1;
        LAS unsigned char* Oc = L + cur * OB; LAS unsigned char* On = L + (cur ^ 1) * OB;
        LAS bf16_t* sQ = (LAS bf16_t*)Oc; LAS bf16_t* sK = (LAS bf16_t*)(Oc + 9216); LAS bf16_t* sV = (LAS bf16_t*)(Oc + 18432); LAS bf16_t* sWV = (LAS bf16_t*)(Oc + 29696);
        const LAS float* tg = tabG + (c < 0 ? 0 : c) * 64; const LAS float* tm = tabM + (c < 0 ? 0 : c) * 64; const LAS float* tb = tabB + (c < 0 ? 0 : c) * 64;
        float m_out = 0.f, decay = 1.f;
        if (c >= 0) {
            if (MODE == 0) { const float mm_end = fmaxf(m_in, tm[63]); decay = __expf(m_in - mm_end); m_out = tb[63] + mm_end; }
            else decay = __expf(tg[63]);
#pragma unroll
            for (int i = 0; i < 2; ++i) { const int idx = wave + 8 * i, stile = idx >> 2, ttile = idx & 3;
                f32x4 acc = {0.f, 0.f, 0.f, 0.f}; acc = mma64(sK + stile * 16 * LS, sQ + ttile * 16 * LS, lane, acc);
                const int t = ttile * 16 + r16, s0 = stile * 16 + 4 * q4;
                const float bt = (MODE == 0) ? -fmaxf(m_in, tm[t]) : tg[t];
                float o[4];
#pragma unroll
                for (int j = 0; j < 4; ++j) { const int s = s0 + j;
                    const float e = (MODE == 0) ? __expf(tg[s] + bt) : __expf(bt - tg[s]) * tm[s];
                    o[j] = (s <= t) ? acc[j] * e : 0.f; }
                u32x2 w; w.x = pk2(o[0], o[1]); w.y = pk2(o[2], o[3]); *(LAS u32x2*)(sS + t * LS + s0) = w; }
        }
        LDS_BARRIER();
        if (c >= 1) WRITEOUT(c - 1);
        if (c >= 0) {
            LAS bf16_t* sCc = sC + cur * 80 * LS; LAS bf16_t* sCn = sC + (cur ^ 1) * 80 * LS;
#pragma unroll
            for (int i = 0; i < 2; ++i) { const int idx = wave + 8 * i, vtile = idx >> 2, ttile = idx & 3; const int t = ttile * 16 + r16;
                f32x4 a = {0.f, 0.f, 0.f, 0.f}; a = mma64(sCc + vtile * 16 * LS, sQ + ttile * 16 * LS, lane, a);
                const float dl = (MODE == 0) ? __expf(m_in - fmaxf(m_in, tm[t])) : __expf(tg[t]);
                a = a * dl;
#pragma unroll
                for (int kk = 0; kk < 2; ++kk) { const bf16x8 fa = tr_frag(sV, LSV, vtile, kk, lane); const bf16x8 fb = *(const LAS bf16x8*)(sS + (ttile * 16 + r16) * LS + kk * 32 + q4 * 8);
                    a = __builtin_amdgcn_mfma_f32_16x16x32_bf16(fa, fb, a, 0, 0, 0); }
                res[i] = a; }
            if (MODE == 0 && wave < 4) { const int t = wave * 16 + r16;
                f32x4 a = {0.f, 0.f, 0.f, 0.f}; a = mma64(sCc + 64 * LS, sQ + wave * 16 * LS, lane, a);
                a = a * __expf(m_in - fmaxf(m_in, tm[t]));
#pragma unroll
                for (int kk = 0; kk < 2; ++kk) { const bf16x8 fa = tr_frag(sV, LSV, 4, kk, lane); const bf16x8 fb = *(const LAS bf16x8*)(sS + (wave * 16 + r16) * LS + kk * 32 + q4 * 8);
                    a = __builtin_amdgcn_mfma_f32_16x16x32_bf16(fa, fb, a, 0, 0, 0); }
                if (q4 == 0) rden[t] = a[0]; }
#pragma unroll
            for (int i = 0; i < 2; ++i) { const int idx = wave + 8 * i, ktile = idx >> 2, vtile = idx & 3;
                f32x4 a = st[i] * decay;
#pragma unroll
                for (int kk = 0; kk < 2; ++kk) { const bf16x8 fa = tr_frag(sK, LS, ktile, kk, lane); const bf16x8 fb = tr_frag(sWV, LSV, vtile, kk, lane);
                    a = __builtin_amdgcn_mfma_f32_16x16x32_bf16(fa, fb, a, 0, 0, 0); }
                st[i] = a;
                u32x2 w; w.x = pk2(a[0], a[1]); w.y = pk2(a[2], a[3]); *(LAS u32x2*)(sCn + (vtile * 16 + r16) * LS + ktile * 16 + 4 * q4) = w; }
            if (MODE == 0 && wave >= 4) { const int ktile = wave - 4;
                f32x4 a = stx * decay;
#pragma unroll
                for (int kk = 0; kk < 2; ++kk) { const bf16x8 fa = tr_frag(sK, LS, ktile, kk, lane); const bf16x8 fb = tr_frag(sWV, LSV, 4, kk, lane);
                    a = __builtin_amdgcn_mfma_f32_16x16x32_bf16(fa, fb, a, 0, 0, 0); }
                stx = a;
                u32x2 w; w.x = pk2(a[0], a[1]); w.y = pk2(a[2], a[3]); *(LAS u32x2*)(sCn + (64 + r16) * LS + ktile * 16 + 4 * q4) = w; }
        }
        if (c + 1 < 36 && ((c + 1) & 1) == wpar) {
            const int cn = c + 1;
            LAS bf16_t* nQ = (LAS bf16_t*)On; LAS bf16_t* nK = (LAS bf16_t*)(On + 9216); LAS bf16_t* nV = (LAS bf16_t*)(On + 18432); LAS bf16_t* nWV = (LAS bf16_t*)(On + 29696);
            float om;
            if (MODE == 0) om = __expf(tabG[cn * 64 + lane] - fmaxf(m_out, tabM[cn * 64 + 63]));
            else om = __expf(tabG[cn * 64 + 63] - tabG[cn * 64 + lane]) * tabM[cn * 64 + lane];
            if (MODE == 0 && (wave >> 1) == 0) nWV[lane * LSV + 64] = (bf16_t)f2bf(om);
            *(LAS u32x4*)(nQ + lane * LS + w8) = r0; *(LAS u32x4*)(nQ + lane * LS + w8 + 8) = r3;
            *(LAS u32x4*)(nK + lane * LS + w8) = r1; *(LAS u32x4*)(nK + lane * LS + w8 + 8) = r4;
            *(LAS u32x4*)(nV + lane * LSV + w8) = r2; *(LAS u32x4*)(nV + lane * LSV + w8 + 8) = r5;
            { u32x4 wv; wv.x = pk2(bf_lo(r2.x) * om, bf_hi(r2.x) * om); wv.y = pk2(bf_lo(r2.y) * om, bf_hi(r2.y) * om); wv.z = pk2(bf_lo(r2.z) * om, bf_hi(r2.z) * om); wv.w = pk2(bf_lo(r2.w) * om, bf_hi(r2.w) * om);
              *(LAS u32x4*)(nWV + lane * LSV + w8) = wv;
              wv.x = pk2(bf_lo(r5.x) * om, bf_hi(r5.x) * om); wv.y = pk2(bf_lo(r5.y) * om, bf_hi(r5.y) * om); wv.z = pk2(bf_lo(r5.z) * om, bf_hi(r5.z) * om); wv.w = pk2(bf_lo(r5.w) * om, bf_hi(r5.w) * om);
              *(LAS u32x4*)(nWV + lane * LSV + w8 + 8) = wv; }
            if (c + 3 < 36) PREFETCH(c + 3);
        }
        LDS_BARRIER();
        if (c >= 0) {
            const bool isctx = c < 4; const int cc = isctx ? c : c - 4; const int Lseg = isctx ? CTXL : SEQL; const int base = isctx ? RL + b * CTXL : b * SEQL;
#pragma unroll
            for (int i = 0; i < 2; ++i) { const int idx = wave + 8 * i, vtile = idx >> 2, ttile = idx & 3; const int t = ttile * 16 + r16, v0 = vtile * 16 + 4 * q4;
                f32x4 a = res[i];
                if (MODE == 0) { const float mmt = fmaxf(m_in, tm[t]); const float dn = rden[t]; a = a * __builtin_amdgcn_rcpf(fmaxf(fabsf(dn), __expf(-(tb[t] + mmt)))); }
                else if (d == 0) {
#pragma unroll
                    for (int j = 0; j < 1; ++j) { const u32x2 xv = *(const LAS u32x2*)(sV + t * LSV + v0); a[0] += dskip * bf_lo(xv.x); a[1] += dskip * bf_hi(xv.x); a[2] += dskip * bf_lo(xv.y); a[3] += dskip * bf_hi(xv.y); } }
                u32x2 w; w.x = pk2(a[0], a[1]); w.y = pk2(a[2], a[3]);
                *(LAS u32x2*)(sO + t * LS + v0) = w; }
        }
        m_in = m_out;
    }
    LDS_BARRIER();
    WRITEOUT(35);
#undef WRITEOUT
#undef PREFETCH
}

__device__ __forceinline__ void rg_unit(const Params& p, LAS unsigned char* L, int l, int b, int n, int d) {
    const int tid = tid_opaque(), lane = tid & 63, wave = __builtin_amdgcn_readfirstlane(tid >> 6);
    const int tt = tid >> 3, cg8 = (tid & 7) * 8, r16 = lane & 15, q4 = lane >> 4;
    LAS bf16_t* sXb = (LAS bf16_t*)(L + 0); LAS bf16_t* sWt = (LAS bf16_t*)(L + 9216);
    LAS float* sXf = (LAS float*)(L + 27648); LAS float* sA = (LAS float*)(L + 44288); LAS float* sU = (LAS float*)(L + 60928); LAS float* sH = (LAS float*)(L + 77568);
    LAS float* sv = (LAS float*)(L + 95488);
    LAS float* sSeg = (LAS float*)(L + 96256);
    const bf16_t* CV = (const bf16_t*)(p.ws + WS_CV);
    bf16_t* outp = (bf16_t*)(p.ws + (d ? WS_RAWB : WS_XN));
    __syncthreads();
    for (int i = tid; i < 2 * 64 * 64; i += NTHREADS) { const int g = i >> 12, c = (i >> 6) & 63, dd = i & 63;
        const float v = p.in[I_WRG][((size_t)((((l * 2 + d) * 2 + g) * 4 + n) * 64 + c)) * 64 + dd]; sWt[(g * 64 + dd) * LS + c] = (bf16_t)f2bf(v); }
    if (tid < 64) { sv[tid] = p.in[I_BRG][((l * 2 + d) * 2 + 0) * 256 + n * 64 + tid]; sv[64 + tid] = p.in[I_BRG][((l * 2 + d) * 2 + 1) * 256 + n * 64 + tid];
        sv[128 + tid] = softplusf_(-p.in[I_LAM][(l * 2 + d) * 256 + n * 64 + tid]); }
    float hstate = 0.f;
    u32x4 rx = {0u, 0u, 0u, 0u};
    for (int c = -1; c < 36; ++c) {
        if (c >= 0) {
            float v[8] = {bf_lo(rx.x), bf_hi(rx.x), bf_lo(rx.y), bf_hi(rx.y), bf_lo(rx.z), bf_hi(rx.z), bf_lo(rx.w), bf_hi(rx.w)};
            *(LAS u32x4*)(sXb + tt * LS + cg8) = rx;
#pragma unroll
            for (int i = 0; i < 8; ++i) sXf[tt * 65 + cg8 + i] = v[i];
            LDS_BARRIER();
        }
        if (c + 1 < 36) {
            const int cn = c + 1; const bool isctx = cn < 4; const int cc = isctx ? cn : cn - 4; const int Lseg = isctx ? CTXL : SEQL;
            const int pos = cc * 64 + tt; const int pf = d ? Lseg - 1 - pos : pos;
            const int row = isctx ? RL + b * CTXL + pf : b * SEQL + (pf & 31) * 64 + (pf >> 5);
            rx = *(const u32x4*)(CV + (size_t)row * PALD + 1280 + n * 64 + cg8);
        }
        if (c >= 0) {
            { const int jt = wave & 3, dp = wave >> 2;
#pragma unroll
              for (int i = 0; i < 2; ++i) { const int dtile = 2 * dp + i;
                  f32x4 a0 = {0.f, 0.f, 0.f, 0.f}, a1 = {0.f, 0.f, 0.f, 0.f};
                  a0 = mma64(sXb + jt * 16 * LS, sWt + (dtile * 16) * LS, lane, a0);
                  a1 = mma64(sXb + jt * 16 * LS, sWt + (64 + dtile * 16) * LS, lane, a1);
                  const int dd = dtile * 16 + r16, j0 = jt * 16 + 4 * q4; const float br = sv[dd], bi = sv[64 + dd], sp = sv[128 + dd];
#pragma unroll
                  for (int jj = 0; jj < 4; ++jj) { const float rr = sigmoidf_(a0[jj] + br), ii = sigmoidf_(a1[jj] + bi); const float la = -8.f * rr * sp;
                      const float a = __expf(la); const float u = __builtin_amdgcn_sqrtf(fmaxf(1.f - a * a, 0.f)) * ii * sXf[(j0 + jj) * 65 + dd];
                      sA[(j0 + jj) * 65 + dd] = a; sU[(j0 + jj) * 65 + dd] = u; } } }
            LDS_BARRIER();
            { float pp[8], uu[8]; float P = 1.f, U = 0.f;
#pragma unroll
              for (int j = 0; j < 8; ++j) { const float a = sA[(wave * 8 + j) * 65 + lane], u = sU[(wave * 8 + j) * 65 + lane]; P = a * P; U = a * U + u; pp[j] = P; uu[j] = U; }
              sSeg[wave * 64 + lane] = P; sSeg[512 + wave * 64 + lane] = U;
              LDS_BARRIER();
              float h = hstate, hin = hstate;
#pragma unroll
              for (int s = 0; s < 8; ++s) { if (s == wave) hin = h; h = sSeg[s * 64 + lane] * h + sSeg[512 + s * 64 + lane]; }
              hstate = h;
#pragma unroll
              for (int j = 0; j < 8; ++j) sH[(wave * 8 + j) * 65 + lane] = pp[j] * hin + uu[j]; }
            LDS_BARRIER();
            { const bool isctx = c < 4; const int cc = isctx ? c : c - 4; const int Lseg = isctx ? CTXL : SEQL;
              const int pos = cc * 64 + tt; const int pf = d ? Lseg - 1 - pos : pos;
              const int row = isctx ? RL + b * CTXL + pf : b * SEQL + (pf & 31) * 64 + (pf >> 5);
              const LAS float* hp = sH + tt * 65 + cg8;
              u32x4 w; w.x = pk2(hp[0], hp[1]); w.y = pk2(hp[2], hp[3]); w.z = pk2(hp[4], hp[5]); w.w = pk2(hp[6], hp[7]);
              st16_wt(outp + (size_t)row * D + 768 + n * 64 + cg8, w); }
        }
    }
}
__device__ __forceinline__ void scan_phase(const Params& p, LAS unsigned char* L, int l) {
    for (int u = blockIdx.x; u < 256; u += gridDim.x) {
        if (u < 64) seq_unit<0>(p, L, l, u >> 3, (u & 7) >> 1, u & 1);
        else if (u < 192) { const int v = u - 64; seq_unit<1>(p, L, l, v >> 4, (v & 15) >> 1, v & 1); }
        else { const int v = u - 192; rg_unit(p, L, l, v >> 3, (v & 7) >> 1, v & 1); }
    }
}

__global__ void __launch_bounds__(NTHREADS, 2) fwd_kernel(Params p) {
    extern __shared__ __attribute__((aligned(16))) unsigned char lds_raw[];
    LAS unsigned char* L = (LAS unsigned char*)lds_raw;
    if (threadIdx.x < 4) ((LAS unsigned*)(L + LDS_BARST))[threadIdx.x] = 0u;
    __syncthreads();
    (void)xcd_barrier_post((unsigned*)(p.ws + WS_CTL), (volatile LAS unsigned*)(L + LDS_BARST));
#pragma unroll 1
    for (int ph = p.lo; ph < p.hi; ++ph) {
        Params pl = p; { unsigned char* w_ = pl.ws; asm volatile("" : "+s"(w_)); pl.ws = w_; }
        if (ph == 0) phase0(pl, L);
        else if (ph == NPHASES - 1) final_phase(pl);
        else {
            const int l = (ph - 1) / 10, k = (ph - 1) - 10 * l;
            if (k == 9 && l == 1) continue;
            if (k == 0) normmod_phase(pl, l, 0);
            else if (k == 6) normmod_phase(pl, l, 1);
            else if (k == 2) conv_phase(pl, L, l);
            else if (k == 3) scan_phase(pl, L, l);
            else if (k == 4) finalize_phase(pl, l, l == 0 ? RT : RL);
            else {
                const unsigned char* wt = pl.ws + WS_WT + (size_t)l * WT_LAYER;
                const int Mrest = l == 0 ? RT : RL;
                pg8::Gemm g; EpiAll E; E.pp = &pl; E.l = l; Order S; S.nslice = 0;
                if (k == 1)      { g.A = (const pg8::bf16_t*)(pl.ws + WS_XN); g.Bt = (const pg8::bf16_t*)wt;            g.M = RT;    g.N = PINP; g.K = D;  g.ld = D;  E.kind = 0; }
                else if (k == 5) { g.A = (const pg8::bf16_t*)(pl.ws + WS_XN); g.Bt = (const pg8::bf16_t*)(wt + WT_OUT); g.M = Mrest; g.N = D;    g.K = D;  g.ld = D;  E.kind = 1; }
                else if (k == 7) { g.A = (const pg8::bf16_t*)(pl.ws + WS_XN); g.Bt = (const pg8::bf16_t*)(wt + WT_W1);  g.M = Mrest; g.N = FF;   g.K = D;  g.ld = D;  E.kind = 2; }
                else if (k == 8) { g.A = (const pg8::bf16_t*)(pl.ws + WS_H);  g.Bt = (const pg8::bf16_t*)(wt + WT_W2);  g.M = RL;    g.N = D;    g.K = FF; g.ld = FF; E.kind = 3; }
                else             { g.A = (const pg8::bf16_t*)(pl.ws + WS_H) + (size_t)RL * FF; g.Bt = (const pg8::bf16_t*)(wt + WT_W2); g.M = RC; g.N = D; g.K = FF / 4; g.ld = FF; E.kind = 4; S.nslice = 4; }
                S.so.init(g.M, g.N, (int)gridDim.x, (int)blockIdx.x);
                pg8::gemm_phase<EpiAll, Order, true, true>(L, g, S, E);
            }
        }
        if (ph + 1 < p.hi) { XcdBarrier bar; bar.bar = (unsigned*)(pl.ws + WS_CTL); bar.x = xb_xcc_id(); bar.st = (volatile LAS unsigned*)(L + LDS_BARST); xcd_barrier(bar); }
    }
}

extern "C" void kernel_launch(void* const* d_in, const int* in_sizes, int n_in, void* d_out, int out_size, void* d_ws, size_t ws_size, hipStream_t stream) {
    static int grid = 0;
    if (grid == 0) {
        if (n_in != 31 || out_size != RL * D || ws_size < WS_END) { fprintf(stderr, "kernel_launch: unexpected problem (n_in %d out %d ws %zu)\n", n_in, out_size, ws_size); grid = -1; return; }
        int dev = 0, cus = 0, per_cu = 0;
        (void)hipGetDevice(&dev); (void)hipDeviceGetAttribute(&cus, hipDeviceAttributeMultiprocessorCount, dev);
        if (hipFuncSetAttribute((const void*)fwd_kernel, hipFuncAttributeMaxDynamicSharedMemorySize, LDS_BYTES) != hipSuccess) { fprintf(stderr, "kernel_launch: hipFuncSetAttribute failed\n"); grid = -1; return; }
        if (hipOccupancyMaxActiveBlocksPerMultiprocessor(&per_cu, (const void*)fwd_kernel, NTHREADS, LDS_BYTES) != hipSuccess || per_cu < 1) { fprintf(stderr, "kernel_launch: occupancy query says %d\n", per_cu); per_cu = 1; }
        (void)hipGetLastError();
        if (per_cu > 1) per_cu = 1;
        grid = cus * per_cu;
        if (grid > 256) grid = 256;
    }
    if (grid < 0) return;
    Params p{};
    for (int i = 0; i < 31; ++i) p.in[i] = (const float*)d_in[i];
    p.out = (float*)d_out; p.ws = (unsigned char*)d_ws;
    (void)hipMemsetAsync((unsigned char*)d_ws + WS_CTL, 0, CTL_BYTES, stream);
#if MK_N_LAUNCHES == 1
    p.lo = 0; p.hi = NPHASES;
    hipLaunchKernelGGL(fwd_kernel, dim3(grid), dim3(NTHREADS), LDS_BYTES, stream, p);
    hipError_t e = hipPeekAtLastError();
    if (e != hipSuccess) fprintf(stderr, "launch failed: %s (grid %d)\n", hipGetErrorString(e), grid);
#else
    for (int k = 0; k < NPHASES; ++k) { p.lo = k; p.hi = k + 1; hipLaunchKernelGGL(fwd_kernel, dim3(grid), dim3(NTHREADS), LDS_BYTES, stream, p); }
#endif
}
```

```cpp
#include <hip/hip_runtime.h>
#include <hip/hip_cooperative_groups.h>
#include <cstdio>
#include <cstdint>
namespace cg = cooperative_groups;
__device__ __forceinline__ int tid_opaque() { int t = threadIdx.x; asm volatile("" : "+v"(t)); return t; }
namespace pg8 {
#define PG8_LAS __attribute__((address_space(3)))
typedef unsigned short bf16_t;
typedef short bf16x8 __attribute__((ext_vector_type(8)));
typedef float f32x4 __attribute__((ext_vector_type(4)));
typedef unsigned u32x4 __attribute__((ext_vector_type(4)));
constexpr int BM = 256, BK = 64, HALF = 128, HTB = HALF * BK * 2  , STAGE_BYTES = 8 * HTB, NXCD = 8, WGM = 8;

__host__ __device__ __forceinline__ int lds_byte(int r, int c) { const int st = (r >> 4) * 2 + (c >> 5), rr = r & 15, cc = c & 31, ob = rr * 64 + cc * 2; return st * 1024 + (ob ^ (((ob >> 9) & 1) << 5)); }
__host__ __device__ __forceinline__ void stage_rc(int b, int& R, int& C) { const int st = b / 1024, sb = b % 1024, swz = sb ^ (((sb >> 9) & 1) << 5); R = (st >> 1) * 16 + swz / 64; C = (st & 1) * 32 + (swz % 64) / 2; }
__host__ __device__ __forceinline__ int perm32(int rho) { const int n = rho >> 4, i = rho & 15; return 8 * (i >> 2) + 4 * n + (i & 3); }

struct Unit { int pm, pn, ks; };
struct Gemm { const bf16_t* A; const bf16_t* Bt; int M, N, K, ld; };

struct StaticOrder {
    int nM, nN, nwg, G, c;
    __host__ __device__ void init(int M, int N, int G_, int c_) { nM = M / BM; nN = N / BM; nwg = nM * nN; G = G_; c = c_; }
    __host__ __device__ bool next(int i, Unit& u) const {
        const long L = (long)i * G + c; if (L >= nwg) return false;
        int wgid = (int)L; { const int q = nwg / NXCD, r = nwg % NXCD, xcd = wgid % NXCD, off = wgid / NXCD; wgid = (xcd < r ? xcd * (q + 1) : r * (q + 1) + (xcd - r) * q) + off; }
        const int nig = WGM * nN, gid = wgid / nig, fm = gid * WGM, gsz = (nM - fm) < WGM ? (nM - fm) : WGM;
        u.pm = fm + ((wgid % nig) % gsz); u.pn = (wgid % nig) / gsz; u.ks = 0; return true;
    }
    __device__ __forceinline__ void a_ready(const Unit&) const {}
    __device__ __forceinline__ void done(const Unit&) const {}
};

__device__ __forceinline__ unsigned cvt_pk_bf16(float lo, float hi) { unsigned r; asm volatile("v_cvt_pk_bf16_f32 %0, %1, %2" : "=v"(r) : "v"(lo), "v"(hi)); return r; }
typedef float f32x2 __attribute__((ext_vector_type(2)));
template <class Epi, class Sched, bool ALIGN_EPI = false, bool SP2 = false>
__device__ __forceinline__ void gemm_phase(PG8_LAS unsigned char* lds, const Gemm g, const Sched& S, const Epi& E) {
    const int tid = tid_opaque(), wid = __builtin_amdgcn_readfirstlane(tid >> 6), lane = tid & 63, wr = wid >> 2, wc = wid & 3, fr = lane & 15, fq = lane >> 4;
    const int K = g.K, nt = K / BK, ld = g.ld;
    unsigned voffA[2], voffB[2];
#pragma unroll
    for (int i = 0; i < 2; ++i) { int R, C; stage_rc(tid * 16 + i * 8192, R, C); const int Rb = Epi::PERM ? ((R & ~31) + perm32(R & 31)) : R;
        voffA[i] = (unsigned)(R * ld + C) * 2u; voffB[i] = (unsigned)(Rb * ld + C) * 2u; }
    const size_t kstep = (size_t)(BK * 2);
    const size_t hstep = (size_t)HALF * ld * 2;
    const size_t tstep = 2 * hstep;
    const unsigned ldsw = (unsigned)wid * 1024u;
    const int aoff = lds_byte(wr * 64 + fr, fq * 8), boff = lds_byte(wc * 32 + fr, fq * 8);
#define PG8_SA(b, h) (((b) * 2 + (h)) * HTB)
#define PG8_SB(b, h) ((4 + (b) * 2 + (h)) * HTB)
#define PG8_STAGE(bufoff, gbase, voff) do { _Pragma("unroll") for (int _i = 0; _i < 2; ++_i) \
        __builtin_amdgcn_global_load_lds((const unsigned*)((const char*)(gbase) + (voff)[_i]), (PG8_LAS unsigned*)(lds + (bufoff) + ldsw + _i * 8192), 16, 0, 0); } while (0)
#define PG8_LDA(dst, b, h) do { _Pragma("unroll") for (int m = 0; m < 4; ++m) _Pragma("unroll") for (int k = 0; k < 2; ++k) dst[m][k] = *(const PG8_LAS bf16x8*)(lds + PG8_SA(b, h) + aoff + m * 2048 + k * 1024); } while (0)
#define PG8_LDB(dst, b, h) do { _Pragma("unroll") for (int n = 0; n < 2; ++n) _Pragma("unroll") for (int k = 0; k < 2; ++k) dst[n][k] = *(const PG8_LAS bf16x8*)(lds + PG8_SB(b, h) + boff + n * 2048 + k * 1024); } while (0)
#define PG8_MMA(ai, bj, At, Bt) do { __builtin_amdgcn_s_setprio(1); _Pragma("unroll") for (int m = 0; m < 4; ++m) _Pragma("unroll") for (int n = 0; n < 2; ++n) _Pragma("unroll") for (int k = 0; k < 2; ++k) \
        acc[ai][bj][m][n] = __builtin_amdgcn_mfma_f32_16x16x32_bf16(Bt[n][k], At[m][k], acc[ai][bj][m][n], 0, 0, 0); __builtin_amdgcn_s_setprio(0); } while (0)
#define PG8_WAIT_V(n) asm volatile("s_waitcnt vmcnt(" #n ")" ::: "memory")
#define PG8_WAIT_L(n) asm volatile("s_waitcnt lgkmcnt(" #n ")" ::: "memory")
#define PG8_BAR __builtin_amdgcn_s_barrier()
#define PG8_SCHED __builtin_amdgcn_sched_barrier(0)
    Unit cur, nxt; int ui = 0;
    if (!S.next(0, cur)) return;
    f32x4 acc[2][2][4][2];
#pragma unroll
    for (int a = 0; a < 2; ++a)
#pragma unroll
        for (int b = 0; b < 2; ++b)
#pragma unroll
            for (int m = 0; m < 4; ++m)
#pragma unroll
                for (int n = 0; n < 2; ++n) acc[a][b][m][n] = (f32x4){0.f, 0.f, 0.f, 0.f};
    bf16x8 At[4][2], B0[2][2], B1[2][2];
    const size_t sstep = (size_t)K * 2;
    const char* cA = (const char*)g.A + (size_t)cur.pm * tstep + (size_t)cur.ks * sstep; const char* cB = (const char*)g.Bt + (size_t)cur.pn * tstep + (size_t)cur.ks * sstep;
    S.a_ready(cur);
    if constexpr (SP2) {
        PG8_STAGE(PG8_SB(0, 0), cB, voffB); PG8_STAGE(PG8_SB(0, 1), cB + hstep, voffB); PG8_STAGE(PG8_SA(0, 0), cA, voffA); PG8_STAGE(PG8_SA(0, 1), cA + hstep, voffA);
        if (wr == 1) PG8_BAR;
        PG8_WAIT_V(2); PG8_BAR;
        PG8_STAGE(PG8_SB(1, 0), cB + kstep, voffB); PG8_STAGE(PG8_SA(1, 0), cA + kstep, voffA); PG8_STAGE(PG8_SB(1, 1), cB + hstep + kstep, voffB);
        PG8_WAIT_V(6); PG8_BAR;
    } else {
        PG8_STAGE(PG8_SB(0, 0), cB, voffB); PG8_STAGE(PG8_SA(0, 0), cA, voffA); PG8_STAGE(PG8_SB(0, 1), cB + hstep, voffB); PG8_STAGE(PG8_SA(0, 1), cA + hstep, voffA);
        if (wr == 1) PG8_BAR;
        PG8_WAIT_V(4); PG8_BAR;
        PG8_STAGE(PG8_SB(1, 0), cB + kstep, voffB); PG8_STAGE(PG8_SA(1, 0), cA + kstep, voffA); PG8_STAGE(PG8_SB(1, 1), cB + hstep + kstep, voffB);
        PG8_WAIT_V(6); PG8_BAR;
    }
    for (;;) {
        const bool has_next = S.next(ui + 1, nxt);
        const char* nA = has_next ? (const char*)g.A + (size_t)nxt.pm * tstep + (size_t)nxt.ks * sstep : cA; const char* nB = has_next ? (const char*)g.Bt + (size_t)nxt.pn * tstep + (size_t)nxt.ks * sstep : cB;
        for (int t = 0; t < nt; t += 2) {
            const bool last = (t == nt - 2);
            const char* a1 = cA + (size_t)(t + 1) * kstep;
            const char* a2 = last ? nA : cA + (size_t)(t + 2) * kstep; const char* b2 = last ? nB : cB + (size_t)(t + 2) * kstep;
            const char* a3 = a2 + kstep; const char* b3 = b2 + kstep;
            if (last && has_next) S.a_ready(nxt);
            if constexpr (SP2) {
            PG8_LDB(B0, 0, 0); PG8_LDB(B1, 0, 1); PG8_SCHED; PG8_LDA(At, 0, 0); PG8_STAGE(PG8_SA(1, 1), a1 + hstep, voffA);
            PG8_WAIT_V(8); PG8_WAIT_L(0); PG8_BAR; PG8_MMA(0, 0, At, B0); PG8_MMA(0, 1, At, B1); PG8_BAR; PG8_SCHED;
            PG8_LDA(At, 0, 1); PG8_STAGE(PG8_SB(0, 0), b2, voffB); PG8_STAGE(PG8_SB(0, 1), b2 + hstep, voffB); PG8_STAGE(PG8_SA(0, 0), a2, voffA);
            PG8_WAIT_V(8); PG8_WAIT_L(0); PG8_BAR; PG8_MMA(1, 0, At, B0); PG8_MMA(1, 1, At, B1); PG8_BAR; PG8_SCHED;
            PG8_LDB(B0, 1, 0); PG8_LDB(B1, 1, 1); PG8_SCHED; PG8_LDA(At, 1, 0); PG8_STAGE(PG8_SA(0, 1), a2 + hstep, voffA);
            PG8_WAIT_V(8); PG8_WAIT_L(0); PG8_BAR; PG8_MMA(0, 0, At, B0); PG8_MMA(0, 1, At, B1); PG8_BAR; PG8_SCHED;
            PG8_LDA(At, 1, 1); PG8_STAGE(PG8_SB(1, 0), b3, voffB); PG8_STAGE(PG8_SB(1, 1), b3 + hstep, voffB); PG8_STAGE(PG8_SA(1, 0), a3, voffA);
            PG8_WAIT_V(8); PG8_WAIT_L(0); PG8_BAR; PG8_MMA(1, 0, At, B0); PG8_MMA(1, 1, At, B1); PG8_BAR; PG8_SCHED;
            } else {
            PG8_LDB(B0, 0, 0); PG8_SCHED; PG8_LDA(At, 0, 0); PG8_STAGE(PG8_SA(1, 1), a1 + hstep, voffA);
            PG8_WAIT_L(8); PG8_BAR; PG8_WAIT_L(0); PG8_MMA(0, 0, At, B0); PG8_BAR; PG8_SCHED;
            PG8_LDB(B1, 0, 1); PG8_STAGE(PG8_SB(0, 0), b2, voffB);
            PG8_BAR; PG8_WAIT_L(0); PG8_MMA(0, 1, At, B1); PG8_BAR;
            PG8_LDA(At, 0, 1); PG8_STAGE(PG8_SA(0, 0), a2, voffA);
            PG8_BAR; PG8_WAIT_L(0); PG8_MMA(1, 0, At, B0); PG8_BAR; PG8_SCHED;
            PG8_STAGE(PG8_SB(0, 1), b2 + hstep, voffB);
            PG8_WAIT_V(6); PG8_BAR; PG8_MMA(1, 1, At, B1); PG8_BAR;
            PG8_LDB(B0, 1, 0); PG8_SCHED; PG8_LDA(At, 1, 0); PG8_STAGE(PG8_SA(0, 1), a2 + hstep, voffA);
            PG8_WAIT_L(8); PG8_BAR; PG8_WAIT_L(0); PG8_MMA(0, 0, At, B0); PG8_BAR; PG8_SCHED;
            PG8_LDB(B1, 1, 1); PG8_STAGE(PG8_SB(1, 0), b3, voffB);
            PG8_BAR; PG8_WAIT_L(0); PG8_MMA(0, 1, At, B1); PG8_BAR;
            PG8_LDA(At, 1, 1); PG8_STAGE(PG8_SA(1, 0), a3, voffA);
            PG8_BAR; PG8_WAIT_L(0); PG8_MMA(1, 0, At, B0); PG8_BAR; PG8_SCHED;
            PG8_STAGE(PG8_SB(1, 1), b3 + hstep, voffB);
            PG8_WAIT_V(6); PG8_BAR; PG8_MMA(1, 1, At, B1); PG8_BAR;
            }
        }
        if constexpr (ALIGN_EPI) { if (wr == 0) PG8_BAR; }
        if constexpr (!Epi::AFTER_DRAIN) { E(acc, cur, wr, wc, fr, fq); S.done(cur); }
        if (!has_next) break;
#pragma unroll
        for (int a = 0; a < 2; ++a)
#pragma unroll
            for (int b = 0; b < 2; ++b)
#pragma unroll
                for (int m = 0; m < 4; ++m)
#pragma unroll
                    for (int n = 0; n < 2; ++n) acc[a][b][m][n] = (f32x4){0.f, 0.f, 0.f, 0.f};
        cur = nxt; cA = nA; cB = nB; ++ui;
        if constexpr (ALIGN_EPI) { if (wr == 1) PG8_BAR; }
    }
    PG8_WAIT_V(0);
    if constexpr (!ALIGN_EPI) { if (wr == 0) PG8_BAR; }
    PG8_BAR;
    if constexpr (Epi::AFTER_DRAIN) { E.fused(acc, cur, wr, wc, fr, fq, lds, wid, lane); S.done(cur); }
#undef PG8_SA
#undef PG8_SB
#undef PG8_STAGE
#undef PG8_LDA
#undef PG8_LDB
#undef PG8_MMA
#undef PG8_WAIT_V
#undef PG8_WAIT_L
#undef PG8_BAR
#undef PG8_SCHED
}
}

#ifndef MK_N_LAUNCHES
#define MK_N_LAUNCHES 1
#endif

#define LAS __attribute__((address_space(3)))
typedef unsigned short bf16_t;
typedef unsigned u32x4 __attribute__((ext_vector_type(4)));
typedef unsigned u32x2 __attribute__((ext_vector_type(2)));
typedef float f32x4 __attribute__((ext_vector_type(4)));
typedef float f32x2 __attribute__((ext_vector_type(2)));
typedef short bf16x8 __attribute__((ext_vector_type(8)));

constexpr int D = 1024, NBATCH = 8, SEQL = 2048, CTXL = 256;
constexpr int RL = NBATCH * SEQL;
constexpr int RC = NBATCH * CTXL;
constexpr int RT = RL + RC;
constexpr int PIN = 2848, PINP = 3072, PALD = 1536, PRLD = 1280, FF = 4096;
constexpr float EPS = 1e-6f;
constexpr int NTHREADS = 512, NWAVES = 8;
constexpr int LDS_BYTES = 163840;
constexpr int LDS_BARST = LDS_BYTES - 16;
constexpr int NPHASES = 22;

constexpr size_t MiB = 1u << 20;
constexpr size_t WS_WT = 0;
constexpr size_t WT_LAYER = 24 * MiB, WT_OUT = 6 * MiB, WT_W1 = 8 * MiB, WT_W2 = 16 * MiB;
constexpr size_t WS_XN = 48 * MiB;
constexpr size_t WS_PA = 84 * MiB;
constexpr size_t WS_PR = 138 * MiB;
constexpr size_t WS_CV = 183 * MiB;
constexpr size_t WS_RAWB = 84 * MiB;
constexpr size_t WS_H = 84 * MiB;
constexpr size_t WS_CTXRES = 237 * MiB;
constexpr size_t WS_GATES = 245 * MiB;
constexpr size_t WS_MOD = 248 * MiB;
constexpr size_t WS_CTL = 249 * MiB;
constexpr size_t CTL_BYTES = 16384;
constexpr size_t WS_PART = WS_H;
constexpr size_t WS_END = 250 * MiB;

struct Params { const float* in[31]; float* out; unsigned char* ws; int lo, hi; };

enum { I_X = 0, I_C, I_CTX, I_CCTX, I_WADA, I_BADA, I_GMIX, I_WIN, I_CAW, I_CAB, I_BIG, I_BFG, I_GHA, I_CBW, I_CBB, I_DTB, I_ALOG, I_DSKIP, I_GNB,
       I_CCW, I_CCB, I_WRG, I_BRG, I_LAM, I_WOUT, I_GMLP, I_W1, I_B1, I_W2, I_B2, I_GFIN };

__device__ __forceinline__ unsigned f2bf(float f) { unsigned u = __builtin_bit_cast(unsigned, f); return (u + 0x7fffu + ((u >> 16) & 1u)) >> 16; }
typedef __bf16 bf16x2_t __attribute__((ext_vector_type(2)));
__device__ __forceinline__ unsigned pk2(float lo, float hi) { const f32x2 v = {lo, hi}; const bf16x2_t b = __builtin_convertvector(v, bf16x2_t); return __builtin_bit_cast(unsigned, b); }
__device__ __forceinline__ float bf_lo(unsigned u) { return __builtin_bit_cast(float, u << 16); }
__device__ __forceinline__ float bf_hi(unsigned u) { return __builtin_bit_cast(float, u & 0xffff0000u); }
__device__ __forceinline__ float bf1(unsigned short h) { return __builtin_bit_cast(float, ((unsigned)h) << 16); }
__device__ __forceinline__ float wave_sum(float v) {
#pragma unroll
    for (int o = 1; o < 64; o <<= 1) v += __shfl_xor(v, o);
    return v;
}
__device__ __forceinline__ float sigmoidf_(float x) { return __builtin_amdgcn_rcpf(1.f + __expf(-x)); }
__device__ __forceinline__ float siluf_(float x) { return x * __builtin_amdgcn_rcpf(1.f + __expf(-x)); }
__device__ __forceinline__ float softplusf_(float x) { return fmaxf(x, 0.f) + log1pf(__expf(-fabsf(x))); }
__device__ __forceinline__ float gelu_tanh(float x) { const float u = 0.7978845608028654f * (x + 0.044715f * x * x * x); const float e = __expf(2.f * u); const float th = 1.f - 2.f / (e + 1.f); return 0.5f * x * (1.f + th); }

__device__ __forceinline__ void st16_wt(void* ptr, u32x4 v) { asm volatile("global_store_dwordx4 %0, %1, off sc1\n\ts_nop 1" :: "v"(ptr), "v"(v) : "memory"); }
__device__ __forceinline__ void st16_wt(void* ptr, f32x4 v) { asm volatile("global_store_dwordx4 %0, %1, off sc1\n\ts_nop 1" :: "v"(ptr), "v"(v) : "memory"); }
__device__ __forceinline__ void st8_wt(void* ptr, u32x2 v) { __hip_atomic_store((unsigned long long*)ptr, __builtin_bit_cast(unsigned long long, v), __ATOMIC_RELAXED, __HIP_MEMORY_SCOPE_AGENT); }
__device__ __forceinline__ void st4_wt(float* ptr, float v) { __hip_atomic_store(ptr, v, __ATOMIC_RELAXED, __HIP_MEMORY_SCOPE_AGENT); }
#define LDS_BARRIER() asm volatile("s_waitcnt lgkmcnt(0)\n\ts_barrier" ::: "memory")
constexpr int LS = 72;
__device__ __forceinline__ f32x4 mma64(const LAS bf16_t* A, const LAS bf16_t* Bt, int lane, f32x4 acc) {
    const int r = lane & 15, q = lane >> 4;
#pragma unroll
    for (int kk = 0; kk < 2; ++kk) {
        const bf16x8 a = *(const LAS bf16x8*)(A + r * LS + kk * 32 + q * 8);
        const bf16x8 b = *(const LAS bf16x8*)(Bt + r * LS + kk * 32 + q * 8);
        acc = __builtin_amdgcn_mfma_f32_16x16x32_bf16(a, b, acc, 0, 0, 0);
    }
    return acc;
}

typedef short v4i16_t __attribute__((ext_vector_type(4)));
__device__ __forceinline__ bf16x8 tr_frag(const LAS bf16_t* T, int ld, int ctile, int kk, int lane) {
    const int g = lane >> 4, q = (lane & 15) >> 2, pp = lane & 3;
    const LAS bf16_t* a0 = T + (32 * kk + 8 * g + q) * ld + 16 * ctile + 4 * pp;
    const v4i16_t lo = __builtin_amdgcn_ds_read_tr16_b64_v4i16((LAS v4i16_t*)a0), hi = __builtin_amdgcn_ds_read_tr16_b64_v4i16((LAS v4i16_t*)(a0 + 4 * ld));
    return (bf16x8){lo.x, lo.y, lo.z, lo.w, hi.x, hi.y, hi.z, hi.w};
}
#define XB_TMO      128
#define XB_XCNT(j)  (256  + 64 * (j))
#define XB_XSUB(j)  (1280 + 64 * (j))
#define XB_XGEN(j)  (2304 + 64 * (j))
#define XB_TOP      3328
#define XB_TOPGEN   3392
#define XCD_BAR_WORDS 3456
#define XB_SPIN_CAP (1u << 18)

__device__ __forceinline__ unsigned xb_ld(unsigned* p)              { return __hip_atomic_load(p, __ATOMIC_RELAXED, __HIP_MEMORY_SCOPE_AGENT); }
__device__ __forceinline__ unsigned xb_add(unsigned* p, unsigned v) { return __hip_atomic_fetch_add(p, v, __ATOMIC_RELAXED, __HIP_MEMORY_SCOPE_AGENT); }
__device__ __forceinline__ unsigned xb_xcc_id() { return (unsigned)__builtin_amdgcn_s_getreg((3 << 11) | 20) & 0xFu; }
#define XB_SPIN(cond, bar) do { unsigned _sp = 0; while (cond) { __builtin_amdgcn_s_sleep(1); \
    if ((++_sp & 255u) == 0u) { if (xb_ld(&(bar)[XB_TMO])) break; if (_sp > XB_SPIN_CAP) { atomicAdd(&(bar)[XB_TMO], 1u); break; } } } } while (0)

struct XcdBarrier {
    unsigned* bar; unsigned x;
    volatile LAS unsigned* st;
};

__device__ __forceinline__ XcdBarrier xcd_barrier_post(unsigned* bar, volatile LAS unsigned* st) {
    XcdBarrier b; b.bar = bar; b.x = xb_xcc_id(); b.st = st;
    if (threadIdx.x == 0) (void)xb_add(&bar[XB_XCNT(b.x)], 1u);
    return b;
}
__device__ __forceinline__ void xcd_barrier_complete(unsigned* bar, unsigned x, unsigned& nloc, unsigned& nx) {
    const unsigned G = gridDim.x * gridDim.y * gridDim.z;
    unsigned sum, cnt, mine, sp = 0u;
    for (;;) {
        sum = 0u; cnt = 0u; mine = 0u;
#pragma unroll
        for (unsigned j = 0; j < 16; ++j) { const unsigned c = xb_ld(&bar[XB_XCNT(j)]); sum += c; cnt += (c > 0u) ? 1u : 0u; mine = (j == x) ? c : mine; }
        if (sum == G) break;
        __builtin_amdgcn_s_sleep(1);
        if ((++sp & 255u) == 0u) { if (xb_ld(&bar[XB_TMO])) break; if (sp > XB_SPIN_CAP) { atomicAdd(&bar[XB_TMO], 1u); break; } }
    }
    nloc = mine > 0u ? mine : 1u; nx = cnt > 0u ? cnt : 1u;
}

__device__ __forceinline__ void xcd_barrier(const XcdBarrier& b) {
    asm volatile("s_waitcnt vmcnt(0)" ::: "memory");
    __syncthreads();
    if (threadIdx.x == 0) {
        unsigned* bar = b.bar;
        __builtin_amdgcn_s_waitcnt(0);
        unsigned nloc = b.st[0], nx = b.st[1];
        if (nloc == 0u) { xcd_barrier_complete(bar, b.x, nloc, nx); b.st[0] = nloc; b.st[1] = nx; }
        const unsigned old = xb_add(&bar[XB_XSUB(b.x)], 1u);
        const unsigned gen = old / nloc;
        if (old + 1u == (gen + 1u) * nloc) {
            __builtin_amdgcn_fence(__ATOMIC_RELEASE, "agent");
            asm volatile("s_waitcnt vmcnt(0)" ::: "memory");
            const unsigned og = xb_add(&bar[XB_TOP], 1u);
            const unsigned tg = og / nx;
            if (og + 1u == (tg + 1u) * nx) xb_add(&bar[XB_TOPGEN], 1u);
            else XB_SPIN(xb_ld(&bar[XB_TOPGEN]) == tg, bar);
            __builtin_amdgcn_fence(__ATOMIC_ACQUIRE, "agent");
            xb_add(&bar[XB_XGEN(b.x)], 1u);
            asm volatile("s_waitcnt vmcnt(0)" ::: "memory");
        } else {
            XB_SPIN(xb_ld(&bar[XB_XGEN(b.x)]) == gen, bar);
            __builtin_amdgcn_fence(__ATOMIC_ACQUIRE, "agent");
            asm volatile("s_waitcnt vmcnt(0)" ::: "memory");
        }
    }
    __syncthreads();
}

struct EpiAll {
    static constexpr bool PERM = true, AFTER_DRAIN = false;
    const Params* pp; int kind, l;
    __device__ __forceinline__ void operator()(const pg8::f32x4 (&acc)[2][2][4][2], const pg8::Unit& u, int wr, int wc, int fr, int fq) const {
        const Params& p = *pp;
        if (kind == 0) {
            const int row0 = u.pm * 256 + wr * 64 + fr;
            if (u.pn < 11) {
                const bool pa = u.pn < 6; const int ld = pa ? PALD : PRLD;
                bf16_t* P = (bf16_t*)(p.ws + (pa ? WS_PA : WS_PR));
                const int col0 = (pa ? u.pn : u.pn - 6) * 256 + wc * 32 + 8 * fq;
#pragma unroll
                for (int ai = 0; ai < 2; ++ai)
#pragma unroll
                    for (int m = 0; m < 4; ++m) { bf16_t* rowp = P + (size_t)(row0 + ai * 128 + m * 16) * ld + col0;
#pragma unroll
                        for (int bj = 0; bj < 2; ++bj) { const pg8::f32x4 v0 = acc[ai][bj][m][0], v1 = acc[ai][bj][m][1];
                            u32x4 w; w.x = pg8::cvt_pk_bf16(v0[0], v0[1]); w.y = pg8::cvt_pk_bf16(v0[2], v0[3]); w.z = pg8::cvt_pk_bf16(v1[0], v1[1]); w.w = pg8::cvt_pk_bf16(v1[2], v1[3]);
                            st16_wt(rowp + bj * 128, w); } }
            } else if (wc == 0) {
                float* gates = (float*)(p.ws + WS_GATES);
#pragma unroll
                for (int ai = 0; ai < 2; ++ai)
#pragma unroll
                    for (int m = 0; m < 4; ++m) { float* gp = gates + (size_t)(row0 + ai * 128 + m * 16) * 32 + 8 * fq;
                        st16_wt(gp, acc[ai][0][m][0]); st16_wt(gp + 4, acc[ai][0][m][1]); }
            }
        } else if (kind == 4) {
            bf16_t* part = (bf16_t*)(p.ws + WS_PART) + (size_t)u.ks * RC * D;
            const int row0 = u.pm * 256 + wr * 64 + fr; const int col0 = u.pn * 256 + wc * 32 + 8 * fq;
#pragma unroll
            for (int bj = 0; bj < 2; ++bj)
#pragma unroll
                for (int ai = 0; ai < 2; ++ai)
#pragma unroll
                    for (int m = 0; m < 4; ++m) { const pg8::f32x4 v0 = acc[ai][bj][m][0], v1 = acc[ai][bj][m][1];
                        u32x4 w; w.x = pk2(v0[0], v0[1]); w.y = pk2(v0[2], v0[3]); w.z = pk2(v1[0], v1[1]); w.w = pk2(v1[2], v1[3]);
                        st16_wt(part + (size_t)(row0 + ai * 128 + m * 16) * D + col0 + bj * 128, w); }
        } else if (kind == 2) {
            bf16_t* H = (bf16_t*)(p.ws + WS_H); const float* b1 = p.in[I_B1] + l * FF;
            const int row0 = u.pm * 256 + wr * 64 + fr; const int col0 = u.pn * 256 + wc * 32 + 8 * fq;
#pragma unroll
            for (int bj = 0; bj < 2; ++bj) { const int c = col0 + bj * 128;
                const f32x4 b0 = *(const f32x4*)(b1 + c), bb1 = *(const f32x4*)(b1 + c + 4);
#pragma unroll
                for (int ai = 0; ai < 2; ++ai)
#pragma unroll
                    for (int m = 0; m < 4; ++m) { f32x4 v0 = acc[ai][bj][m][0] + b0, v1 = acc[ai][bj][m][1] + bb1;
#pragma unroll
                        for (int i = 0; i < 4; ++i) { const float a = fmaxf(v0[i], 0.f), b = fmaxf(v1[i], 0.f); v0[i] = a * a; v1[i] = b * b; }
                        u32x4 w; w.x = pg8::cvt_pk_bf16(v0[0], v0[1]); w.y = pg8::cvt_pk_bf16(v0[2], v0[3]); w.z = pg8::cvt_pk_bf16(v1[0], v1[1]); w.w = pg8::cvt_pk_bf16(v1[2], v1[3]);
                        st16_wt(H + (size_t)(row0 + ai * 128 + m * 16) * FF + c, w); } }
        } else {
            const bool lat = u.pm < 64; const int bsel = lat ? (u.pm >> 3) : 8;
            const float* gate = (const float*)(p.ws + WS_MOD) + (size_t)(l * 9 + bsel) * 6144 + (kind == 1 ? 2 : 5) * 1024;
            const float* bias = p.in[I_B2] + l * D;
            const float bsc = kind == 3 ? 1.f : 0.f;
            const int rloc = (lat ? u.pm : u.pm - 64) * 256 + wr * 64 + fr;
            bf16_t* rs = lat ? (bf16_t*)p.out : (bf16_t*)(p.ws + WS_CTXRES);
            const bool f32src = (kind == 1 && l == 0);
            const float* ipf = (lat ? p.in[I_X] : p.in[I_CTX]) + (size_t)rloc * D;
            const bf16_t* ipb = rs + (size_t)rloc * D;
            bf16_t* op = ((kind == 3 && l == 1) ? (bf16_t*)(p.ws + WS_XN) : rs) + (size_t)rloc * D;
            const int col0 = u.pn * 256 + wc * 32 + 8 * fq;
#pragma unroll
            for (int bj = 0; bj < 2; ++bj) { const int c = col0 + bj * 128;
                const f32x4 g0 = *(const f32x4*)(gate + c), g1 = *(const f32x4*)(gate + c + 4);
                const f32x4 b0 = *(const f32x4*)(bias + c) * bsc, b1 = *(const f32x4*)(bias + c + 4) * bsc;
#pragma unroll
                for (int ai = 0; ai < 2; ++ai)
#pragma unroll
                    for (int m = 0; m < 4; ++m) { const size_t ro = (size_t)(ai * 128 + m * 16) * D + c;
                        f32x4 x0, x1;
                        if (f32src) { x0 = *(const f32x4*)(ipf + ro); x1 = *(const f32x4*)(ipf + ro + 4); }
                        else { const u32x4 xb = *(const u32x4*)(ipb + ro); x0 = (f32x4){bf_lo(xb.x), bf_hi(xb.x), bf_lo(xb.y), bf_hi(xb.y)}; x1 = (f32x4){bf_lo(xb.z), bf_hi(xb.z), bf_lo(xb.w), bf_hi(xb.w)}; }
                        const f32x4 y0 = x0 + g0 * (acc[ai][bj][m][0] + b0), y1 = x1 + g1 * (acc[ai][bj][m][1] + b1);
                        u32x4 w; w.x = pk2(y0[0], y0[1]); w.y = pk2(y0[2], y0[3]); w.z = pk2(y1[0], y1[1]); w.w = pk2(y1[2], y1[3]);
                        st16_wt(op + ro, w); } }
        }
    }
};

struct Order {
    pg8::StaticOrder so; int nslice;
    __device__ __forceinline__ bool next(int i, pg8::Unit& u) const {
        if (nslice == 0) return so.next(i, u);
        const int Lx = i * so.G + so.c; if (Lx >= nslice * 32) return false;
        u.ks = Lx >> 5; const int t = Lx & 31; u.pm = t >> 2; u.pn = t & 3; return true;
    }
    __device__ __forceinline__ void a_ready(const pg8::Unit&) const {}
    __device__ __forceinline__ void done(const pg8::Unit&) const {}
};
__device__ __forceinline__ int inproj_dest(int n) {
    if (n < 512) return n;
    if (n < 1024) return 1536 + (n - 512);
    if (n < 1040) return 2816 + (n - 1024);
    if (n < 1552) return 2048 + (n - 1040);
    if (n < 2064) return 512 + (n - 1552);
    if (n < 2320) return 1024 + (n - 2064);
    if (n < 2336) return 2832 + (n - 2320);
    if (n < 2592) return 1280 + (n - 2336);
    return 2560 + (n - 2592);
}
template <bool INMAP>
__device__ __forceinline__ void transpose_item(const float* W, int K, int N, bf16_t* WT, LAS float* scr, int item, int lane) {
    const int nblk = N / 32, kb = item / nblk, nb = item % nblk, k0 = 64 * kb, n0 = 32 * nb;
#pragma unroll 8
    for (int i = 0; i < 32; ++i) { const int kk = 2 * i + (lane >> 5); scr[kk * 33 + (lane & 31)] = W[(size_t)(k0 + kk) * N + n0 + (lane & 31)]; }
    asm volatile("s_waitcnt lgkmcnt(0)" ::: "memory");
    const int c = lane & 7;
#pragma unroll
    for (int j = 0; j < 4; ++j) { const int n = (lane >> 3) + 8 * j; const LAS float* s = scr + (8 * c) * 33 + n;
        u32x4 o; o.x = pk2(s[0 * 33], s[1 * 33]); o.y = pk2(s[2 * 33], s[3 * 33]); o.z = pk2(s[4 * 33], s[5 * 33]); o.w = pk2(s[6 * 33], s[7 * 33]);
        const int row = INMAP ? inproj_dest(n0 + n) : (n0 + n);
        st16_wt(WT + (size_t)row * K + k0 + 8 * c, o); }
    asm volatile("s_waitcnt lgkmcnt(0)" ::: "memory");
}
__device__ __forceinline__ void phase0(const Params& p, LAS unsigned char* L) {
    const int tid = tid_opaque(), lane = tid & 63, wave = tid >> 6;
    LAS float* sS = (LAS float*)L;
    LAS float* red = (LAS float*)(L + 36864);
    for (int i = tid; i < 9 * 1024; i += NTHREADS) { const int v = i >> 10, k = i & 1023; const float x = v < 8 ? p.in[I_C][v * 1024 + k] : p.in[I_CCTX][k]; sS[i] = siluf_(x); }
    __syncthreads();
    float* mod = (float*)(p.ws + WS_MOD);
    for (int unit = blockIdx.x; unit < 192; unit += gridDim.x) {
        const int l = unit / 96, nb = (unit % 96) * 64;
        const float* W = p.in[I_WADA] + (size_t)l * 1024 * 6144 + nb + lane;
        float acc[9];
#pragma unroll
        for (int v = 0; v < 9; ++v) acc[v] = 0.f;
#pragma unroll 8
        for (int k = wave * 128; k < wave * 128 + 128; k += 4) {
            const float w0 = W[(size_t)k * 6144], w1 = W[(size_t)(k + 1) * 6144], w2 = W[(size_t)(k + 2) * 6144], w3 = W[(size_t)(k + 3) * 6144];
#pragma unroll
            for (int v = 0; v < 9; ++v) { const f32x4 s4 = *(const LAS f32x4*)(sS + v * 1024 + k); acc[v] += (s4.x * w0 + s4.y * w1) + (s4.z * w2 + s4.w * w3); } }
#pragma unroll
        for (int v = 0; v < 9; ++v) red[(wave * 9 + v) * 64 + lane] = acc[v];
        __syncthreads();
        for (int i = tid; i < 576; i += NTHREADS) { const int v = i >> 6, ln = i & 63; float s = 0.f;
#pragma unroll
            for (int w = 0; w < 8; ++w) s += red[(w * 9 + v) * 64 + ln];
            st4_wt(mod + (size_t)(l * 9 + v) * 6144 + nb + ln, s + p.in[I_BADA][l * 6144 + nb + ln]); }
        __syncthreads();
    }
    __syncthreads();
    LAS float* scr = (LAS float*)(L + wave * 16384);
    const int gw = blockIdx.x * NWAVES + wave, NGW = gridDim.x * NWAVES;
    constexpr int I_IN = 16 * 89, I_OUT = 16 * 32, I_M1 = 16 * 128, I_M2 = 64 * 32, I_LAYER = I_IN + I_OUT + I_M1 + I_M2;
    const bool bal = (gridDim.x == 256); const int bx = blockIdx.x;
    const int nmine = !bal ? (2 * I_LAYER + NGW - 1) / NGW : (bx >= 192 ? 11 : (bx < 36 ? 5 : 4));
    for (int j = 0; j < nmine; ++j) {
        int it;
        if (!bal) it = gw + j * NGW;
        else if (bx >= 192) it = (bx - 192) * 88 + wave * 11 + j;
        else it = j < 4 ? 5632 + bx * 32 + wave * 4 + j : 11776 + bx * 8 + wave;
        if (it >= 2 * I_LAYER) continue;
        const int l = it / I_LAYER; int r = it % I_LAYER;
        bf16_t* wt = (bf16_t*)(p.ws + WS_WT + (size_t)l * WT_LAYER);
        if (r < I_IN) { transpose_item<true>(p.in[I_WIN] + (size_t)l * 1024 * PIN, 1024, PIN, wt, scr, r, lane); continue; } r -= I_IN;
        if (r < I_OUT) { transpose_item<false>(p.in[I_WOUT] + (size_t)l * 1024 * 1024, 1024, 1024, (bf16_t*)((unsigned char*)wt + WT_OUT), scr, r, lane); continue; } r -= I_OUT;
        if (r < I_M1) { transpose_item<false>(p.in[I_W1] + (size_t)l * 1024 * FF, 1024, FF, (bf16_t*)((unsigned char*)wt + WT_W1), scr, r, lane); continue; } r -= I_M1;
        transpose_item<false>(p.in[I_W2] + (size_t)l * FF * 1024, FF, 1024, (bf16_t*)((unsigned char*)wt + WT_W2), scr, r, lane);
    }
}

__device__ __forceinline__ void normmod_phase(const Params& p, int l, int which) {
    const bool first = (which == 0 && l == 0);
    const float* xlat = p.in[I_X]; const float* xctx = p.in[I_CTX];
    const bf16_t* rlat = (const bf16_t*)p.out; const bf16_t* rctx = (const bf16_t*)(p.ws + WS_CTXRES);
    const int nrows = (l == 1 && which == 1) ? RL : RT;
    const float* g = (which == 0 ? p.in[I_GMIX] : p.in[I_GMLP]) + l * D; const float* modl = (const float*)(p.ws + WS_MOD) + (size_t)l * 9 * 6144;
    const int shi = which == 0 ? 0 : 3, sci = shi + 1;
    const int tid = tid_opaque(), lane = tid & 63, wave = tid >> 6;
    const int gw = blockIdx.x * NWAVES + wave, NGW = gridDim.x * NWAVES;
    bf16_t* XN = (bf16_t*)(p.ws + WS_XN);
    for (int row = gw; row < nrows; row += NGW) {
        const bool lat = row < RL; const int bsel = lat ? (row >> 11) : 8;
        const float* xr = lat ? xlat + (size_t)row * D : xctx + (size_t)(row - RL) * D;
        const bf16_t* xb = lat ? rlat + (size_t)row * D : rctx + (size_t)(row - RL) * D;
        const float* sh = modl + bsel * 6144 + shi * 1024; const float* sc = modl + bsel * 6144 + sci * 1024;
        f32x4 v[4]; float s = 0.f;
        const bool fold = (which == 0 && l == 1 && !lat);
#pragma unroll
        for (int j = 0; j < 4; ++j) { const int cj = 8 * lane + 512 * (j >> 1) + 4 * (j & 1);
            if (first) v[j] = *(const f32x4*)(xr + cj); else { const u32x2 t = *(const u32x2*)(xb + cj); v[j] = (f32x4){bf_lo(t.x), bf_hi(t.x), bf_lo(t.y), bf_hi(t.y)}; }
            if (fold) { const bf16_t* pt = (const bf16_t*)(p.ws + WS_PART) + (size_t)(row - RL) * D + cj;
                f32x4 a = *(const f32x4*)(p.in[I_B2] + cj);
#pragma unroll
                for (int ks = 0; ks < 8; ++ks) { const u32x2 t = *(const u32x2*)(pt + (size_t)ks * RC * D); a = a + (f32x4){bf_lo(t.x), bf_hi(t.x), bf_lo(t.y), bf_hi(t.y)}; }
                v[j] = v[j] + *(const f32x4*)((const float*)(p.ws + WS_MOD) + 8 * 6144 + 5 * 1024 + cj) * a; } s += (v[j].x * v[j].x + v[j].y * v[j].y) + (v[j].z * v[j].z + v[j].w * v[j].w); }
        const float rs = rsqrtf(wave_sum(s) * (1.f / D) + EPS);
#pragma unroll
        for (int h = 0; h < 2; ++h) { const int c = 8 * lane + 512 * h;
            const f32x4 g0 = *(const f32x4*)(g + c), g1 = *(const f32x4*)(g + c + 4), s0 = *(const f32x4*)(sh + c), s1 = *(const f32x4*)(sh + c + 4), c0 = *(const f32x4*)(sc + c), c1 = *(const f32x4*)(sc + c + 4);
            const f32x4 o0 = v[2 * h] * rs * g0 * (c0 + 1.f) + s0, o1 = v[2 * h + 1] * rs * g1 * (c1 + 1.f) + s1;
            u32x4 w; w.x = pk2(o0.x, o0.y); w.y = pk2(o0.z, o0.w); w.z = pk2(o1.x, o1.y); w.w = pk2(o1.z, o1.w);
            st16_wt(XN + (size_t)row * D + c, w); }
    }
}
__device__ __forceinline__ void final_phase(const Params& p) {
    const int tid = tid_opaque(), lane = tid & 63, wave = tid >> 6;
    const int gw = blockIdx.x * NWAVES + wave, NGW = gridDim.x * NWAVES;
    const float* g = p.in[I_GFIN]; const bf16_t* X = (const bf16_t*)(p.ws + WS_XN);
    for (int row = gw; row < RL; row += NGW) {
        const bf16_t* xb = X + (size_t)row * D; float* xr = p.out + (size_t)row * D;
        f32x4 v[4]; float s = 0.f;
#pragma unroll
        for (int j = 0; j < 4; ++j) { const u32x2 t = *(const u32x2*)(xb + 4 * lane + 256 * j); v[j] = (f32x4){bf_lo(t.x), bf_hi(t.x), bf_lo(t.y), bf_hi(t.y)}; s += (v[j].x * v[j].x + v[j].y * v[j].y) + (v[j].z * v[j].z + v[j].w * v[j].w); }
        const float rs = rsqrtf(wave_sum(s) * (1.f / D) + EPS);
#pragma unroll
        for (int j = 0; j < 4; ++j) { const int c = 4 * lane + 256 * j; const f32x4 gg = *(const f32x4*)(g + c); *(f32x4*)(xr + c) = v[j] * rs * gg; }
    }
}
__device__ __forceinline__ void finalize_phase(const Params& p, int l, int nrows) {
    const int tid = tid_opaque(), lane = tid & 63, wave = tid >> 6;
    const int gw = blockIdx.x * NWAVES + wave, NGW = gridDim.x * NWAVES;
    bf16_t* RF = (bf16_t*)(p.ws + WS_XN); const bf16_t* RB = (const bf16_t*)(p.ws + WS_RAWB); const bf16_t* P = (const bf16_t*)(p.ws + WS_PR);
    const float* gha = p.in[I_GHA] + l * 256; const float* gnb = p.in[I_GNB] + l * 512;
    for (int row = gw; row < nrows; row += NGW) {
        bf16_t* rf = RF + (size_t)row * D + 4 * lane; const bf16_t* rb = RB + (size_t)row * D + 4 * lane; const bf16_t* pr = P + (size_t)row * PRLD + 4 * lane;
        float v[4][4];
#pragma unroll
        for (int sgi = 0; sgi < 4; ++sgi) { const u32x2 a = *(const u32x2*)(rf + sgi * 256), b = *(const u32x2*)(rb + sgi * 256);
            v[sgi][0] = bf_lo(a.x) + bf_lo(b.x); v[sgi][1] = bf_hi(a.x) + bf_hi(b.x); v[sgi][2] = bf_lo(a.y) + bf_lo(b.y); v[sgi][3] = bf_hi(a.y) + bf_hi(b.y); }
        const u32x2 ov = *(const u32x2*)(pr + 256), z0 = *(const u32x2*)(pr + 512), z1 = *(const u32x2*)(pr + 768), gv = *(const u32x2*)(pr + 1024);
        { float s = v[0][0] * v[0][0] + v[0][1] * v[0][1] + v[0][2] * v[0][2] + v[0][3] * v[0][3];
#pragma unroll
          for (int o = 1; o < 16; o <<= 1) s += __shfl_xor(s, o);
          const float rs = rsqrtf(s * (1.f / 64.f) + EPS); const f32x4 gg = *(const f32x4*)(gha + 4 * lane);
          v[0][0] = v[0][0] * rs * gg.x * sigmoidf_(bf_lo(ov.x)); v[0][1] = v[0][1] * rs * gg.y * sigmoidf_(bf_hi(ov.x));
          v[0][2] = v[0][2] * rs * gg.z * sigmoidf_(bf_lo(ov.y)); v[0][3] = v[0][3] * rs * gg.w * sigmoidf_(bf_hi(ov.y)); }
        { v[1][0] *= siluf_(bf_lo(z0.x)); v[1][1] *= siluf_(bf_hi(z0.x)); v[1][2] *= siluf_(bf_lo(z0.y)); v[1][3] *= siluf_(bf_hi(z0.y));
          v[2][0] *= siluf_(bf_lo(z1.x)); v[2][1] *= siluf_(bf_hi(z1.x)); v[2][2] *= siluf_(bf_lo(z1.y)); v[2][3] *= siluf_(bf_hi(z1.y));
          float s = 0.f;
#pragma unroll
          for (int i = 0; i < 4; ++i) s += v[1][i] * v[1][i] + v[2][i] * v[2][i];
          const float rs = rsqrtf(wave_sum(s) * (1.f / 512.f) + EPS);
          const f32x4 g0 = *(const f32x4*)(gnb + 4 * lane), g1 = *(const f32x4*)(gnb + 256 + 4 * lane);
#pragma unroll
          for (int i = 0; i < 4; ++i) { v[1][i] = v[1][i] * rs * g0[i]; v[2][i] = v[2][i] * rs * g1[i]; } }
        { v[3][0] *= gelu_tanh(bf_lo(gv.x)); v[3][1] *= gelu_tanh(bf_hi(gv.x)); v[3][2] *= gelu_tanh(bf_lo(gv.y)); v[3][3] *= gelu_tanh(bf_hi(gv.y)); }
#pragma unroll
        for (int sgi = 0; sgi < 4; ++sgi) { u32x2 w; w.x = pk2(v[sgi][0], v[sgi][1]); w.y = pk2(v[sgi][2], v[sgi][3]); st8_wt(rf + sgi * 256, w); }
    }
}

__device__ __forceinline__ void conv_phase(const Params& p, LAS unsigned char* L, int l) {
    const int tid = tid_opaque();
    if (tid >= 384) return;
    const int stream = tid >= 192 ? 1 : 0, cgp = tid - 192 * stream, c0 = cgp * 8;
    float w[5][8];
#pragma unroll
    for (int j = 0; j < 5; ++j)
#pragma unroll
        for (int i = 0; i < 8; ++i) { const int c = c0 + i; float v;
            if (c0 < 512) v = j < 4 ? p.in[I_CAW][(l * 4 + j) * 512 + c] : p.in[I_CAB][l * 512 + c];
            else if (c0 < 1280) v = j < 4 ? p.in[I_CBW][(l * 4 + j) * 768 + (c - 512)] : p.in[I_CBB][l * 768 + (c - 512)];
            else v = j < 4 ? p.in[I_CCW][(l * 4 + j) * 256 + (c - 1280)] : p.in[I_CCB][l * 256 + (c - 1280)];
            w[j][i] = v; }
    const bf16_t* PA = (const bf16_t*)(p.ws + WS_PA); bf16_t* CV = (bf16_t*)(p.ws + WS_CV);
    const bool act = c0 < 1280; const float qs = c0 < 256 ? 0.125f : 1.f;
    for (int it = blockIdx.x; it < 1152; it += gridDim.x) {
        const int seg = 2 * it + stream;
        const bool lat = seg < 2048; const int sb = lat ? seg : seg - 2048;
        const int bb = lat ? (sb >> 8) : (sb >> 5), pf0 = (lat ? (sb & 255) : (sb & 31)) * 8;
        const int Lseg = lat ? SEQL : CTXL, base = lat ? bb * SEQL : RL + bb * CTXL;
        const bool cm = lat && !act;
        u32x4 x[11];
#pragma unroll
        for (int r = 0; r < 11; ++r) { const int pj = pf0 + r - 2; const bool ok = (pj >= 0) && (pj < Lseg); const int pq = ok ? pj : pf0;
            const int tj = cm ? ((pq & 31) * 64 + (pq >> 5)) : pq;
            x[r] = *(const u32x4*)(PA + (size_t)(base + tj) * PALD + c0); if (!ok) x[r] = (u32x4){0u, 0u, 0u, 0u}; }
#pragma unroll
        for (int o = 0; o < 8; ++o) {
            float v[8];
#pragma unroll
            for (int i = 0; i < 8; ++i) v[i] = w[4][i];
#pragma unroll
            for (int j = 0; j < 4; ++j) { const u32x4 x_ = x[o + j];
                v[0] += w[j][0] * bf_lo(x_.x); v[1] += w[j][1] * bf_hi(x_.x); v[2] += w[j][2] * bf_lo(x_.y); v[3] += w[j][3] * bf_hi(x_.y);
                v[4] += w[j][4] * bf_lo(x_.z); v[5] += w[j][5] * bf_hi(x_.z); v[6] += w[j][6] * bf_lo(x_.w); v[7] += w[j][7] * bf_hi(x_.w); }
            if (act) {
#pragma unroll
                for (int i = 0; i < 8; ++i) v[i] = siluf_(v[i]) * qs;
            }
            const int pq = pf0 + o; const int tj = cm ? ((pq & 31) * 64 + (pq >> 5)) : pq;
            u32x4 wv; wv.x = pk2(v[0], v[1]); wv.y = pk2(v[2], v[3]); wv.z = pk2(v[4], v[5]); wv.w = pk2(v[6], v[7]);
            st16_wt(CV + (size_t)(base + tj) * PALD + c0, wv);
        }
    }
}

template <int MODE>
__device__ __forceinline__ void seq_unit(const Params& p, LAS unsigned char* L, int l, int b, int hd, int d) {
    const int tid = tid_opaque(), lane = tid & 63, wave = __builtin_amdgcn_readfirstlane(tid >> 6);
    const int r16 = lane & 15, q4 = lane >> 4;
    const int wpar = wave & 1, w8 = (wave >> 1) * 16;
    constexpr int OB = 40960, LSV = 88;
    LAS bf16_t* sS = (LAS bf16_t*)(L + 81920); LAS bf16_t* sC = (LAS bf16_t*)(L + 91136);
    LAS float* tabG = (LAS float*)(L + 114176); LAS float* tabM = (LAS float*)(L + 123392); LAS float* tabB = (LAS float*)(L + 132608);
    LAS bf16_t* sO = (LAS bf16_t*)(L + 142336);
    LAS float* rden = (LAS float*)(L + 141824);
    const bf16_t* CV = (const bf16_t*)(p.ws + WS_CV);
    const float* G = (const float*)(p.ws + WS_GATES);
    bf16_t* outp = (bf16_t*)(p.ws + (d ? WS_RAWB : WS_XN));
    const bf16_t* P2; int ld2;
    int col0, col1, col2, ocol, gc0, gc1 = 0; float gb0, gb1 = 0.f, Aneg = 0.f, dskip = 0.f;
    if (MODE == 0) { col0 = hd * 64; col1 = 256 + hd * 64; col2 = hd * 64; P2 = (const bf16_t*)(p.ws + WS_PR); ld2 = PRLD; ocol = hd * 64; gc0 = d * 4 + hd; gc1 = 8 + d * 4 + hd;
        gb0 = p.in[I_BIG][(l * 2 + d) * 4 + hd]; gb1 = p.in[I_BFG][(l * 2 + d) * 4 + hd]; }
    else { const int g = hd >> 2; col0 = 1152 + g * 64; col1 = 1024 + g * 64; col2 = 512 + hd * 64; P2 = CV; ld2 = PALD; ocol = 256 + hd * 64; gc0 = 16 + d * 8 + hd;
        gb0 = p.in[I_DTB][(l * 2 + d) * 8 + hd]; Aneg = -__expf(p.in[I_ALOG][(l * 2 + d) * 8 + hd]); dskip = p.in[I_DSKIP][l * 8 + hd]; }
    __syncthreads();
    for (int i = tid; i < 80 * LS / 2; i += NTHREADS) ((LAS unsigned*)sC)[i] = 0u;
    if (MODE == 0 && tid < 128) { LAS unsigned char* ob = L + (tid >> 6) * OB; const int row = tid & 63;
        unsigned z_ = 0u, o_ = 0x00003F80u; asm volatile("" : "+v"(z_), "+v"(o_));
        const u32x4 zz_ = {z_, z_, z_, z_}, oo_ = {o_, z_, z_, z_};
        *(LAS u32x4*)(ob + 18432 + (row * LSV + 64) * 2) = oo_; *(LAS u32x4*)(ob + 18432 + (row * LSV + 72) * 2) = zz_;
        *(LAS u32x4*)(ob + 29696 + (row * LSV + 64) * 2) = zz_; *(LAS u32x4*)(ob + 29696 + (row * LSV + 72) * 2) = zz_; }
    for (int c = wave; c < 36; c += 8) {
        const bool isctx = c < 4; const int cc = isctx ? c : c - 4; const int Lseg = isctx ? CTXL : SEQL; const int base = isctx ? RL + b * CTXL : b * SEQL;
        const int pos0 = cc * 64 + lane; const int tau0 = d ? Lseg - 1 - pos0 : pos0; const float* gp = G + (size_t)(base + tau0) * 32;
        if (MODE == 0) {
            const float ig = gp[gc0] + gb0, fg = gp[gc1] + gb1;
            const float lf = fminf(fg, 0.f) - log1pf(__expf(-fabsf(fg)));
            float bs = lf;
#pragma unroll
            for (int o = 1; o < 64; o <<= 1) { const float t = __shfl_up(bs, o); if (lane >= o) bs += t; }
            const float g = ig - bs; float M = g;
#pragma unroll
            for (int o = 1; o < 64; o <<= 1) { const float t = __shfl_up(M, o); if (lane >= o) M = fmaxf(M, t); }
            tabG[c * 64 + lane] = g; tabM[c * 64 + lane] = M; tabB[c * 64 + lane] = bs;
        } else {
            const float dtv = softplusf_(gp[gc0] + gb0);
            float cs = dtv * Aneg;
#pragma unroll
            for (int o = 1; o < 64; o <<= 1) { const float t = __shfl_up(cs, o); if (lane >= o) cs += t; }
            tabG[c * 64 + lane] = cs; tabM[c * 64 + lane] = dtv;
        }
    }
    f32x4 st[2] = {{0.f, 0.f, 0.f, 0.f}, {0.f, 0.f, 0.f, 0.f}};
    f32x4 stx = {0.f, 0.f, 0.f, 0.f};
    f32x4 res[2] = {{0.f, 0.f, 0.f, 0.f}, {0.f, 0.f, 0.f, 0.f}};
    float m_in = 0.f;
    u32x4 r0, r1, r2, r3, r4, r5;
#define PREFETCH(CN) do { const int cn_ = (CN); const bool isctx_ = cn_ < 4; const int cc_ = isctx_ ? cn_ : cn_ - 4; const int Lseg_ = isctx_ ? CTXL : SEQL; const int base_ = isctx_ ? RL + b * CTXL : b * SEQL; \
        const int pos_ = cc_ * 64 + lane; const int row_ = base_ + (d ? Lseg_ - 1 - pos_ : pos_); \
        r0 = *(const u32x4*)(CV + (size_t)row_ * PALD + col0 + w8); r1 = *(const u32x4*)(CV + (size_t)row_ * PALD + col1 + w8); r2 = *(const u32x4*)(P2 + (size_t)row_ * ld2 + col2 + w8); \
        r3 = *(const u32x4*)(CV + (size_t)row_ * PALD + col0 + w8 + 8); r4 = *(const u32x4*)(CV + (size_t)row_ * PALD + col1 + w8 + 8); r5 = *(const u32x4*)(P2 + (size_t)row_ * ld2 + col2 + w8 + 8); } while (0)
#define WRITEOUT(CP) do { const int cp_ = (CP); const bool isctx_ = cp_ < 4; const int cc_ = isctx_ ? cp_ : cp_ - 4; const int Lseg_ = isctx_ ? CTXL : SEQL; const int base_ = isctx_ ? RL + b * CTXL : b * SEQL; \
        const int tok_ = tid >> 3, grp_ = (tid & 7) * 8; const int pos_ = cc_ * 64 + tok_; const int row_ = base_ + (d ? Lseg_ - 1 - pos_ : pos_); \
        st16_wt(outp + (size_t)row_ * D + ocol + grp_, *(const LAS u32x4*)(sO + tok_ * LS + grp_)); } while (0)
    r0 = r1 = r2 = r3 = r4 = r5 = (u32x4){0u, 0u, 0u, 0u};
    if (wpar == 0) PREFETCH(0); else PREFETCH(1);
    __syncthreads();
    for (int c = -1; c < 36; ++c) {
        const int cur = c & 1;
        LAS unsigned char* Oc = L + cur * OB; LAS unsigned char* On = L + (cur ^ 1) * OB;
        LAS bf16_t* sQ = (LAS bf16_t*)Oc; LAS bf16_t* sK = (LAS bf16_t*)(Oc + 9216); LAS bf16_t* sV = (LAS bf16_t*)(Oc + 18432); LAS bf16_t* sWV = (LAS bf16_t*)(Oc + 29696);
        const LAS float* tg = tabG + (c < 0 ? 0 : c) * 64; const LAS float* tm = tabM + (c < 0 ? 0 : c) * 64; const LAS float* tb = tabB + (c < 0 ? 0 : c) * 64;
        float m_out = 0.f, decay = 1.f;
        if (c >= 0) {
            if (MODE == 0) { const float mm_end = fmaxf(m_in, tm[63]); decay = __expf(m_in - mm_end); m_out = tb[63] + mm_end; }
            else decay = __expf(tg[63]);
#pragma unroll
            for (int i = 0; i < 2; ++i) { const int idx = wave + 8 * i, stile = idx >> 2, ttile = idx & 3;
                f32x4 acc = {0.f, 0.f, 0.f, 0.f}; acc = mma64(sK + stile * 16 * LS, sQ + ttile * 16 * LS, lane, acc);
                const int t = ttile * 16 + r16, s0 = stile * 16 + 4 * q4;
                const float bt = (MODE == 0) ? -fmaxf(m_in, tm[t]) : tg[t];
                float o[4];
#pragma unroll
                for (int j = 0; j < 4; ++j) { const int s = s0 + j;
                    const float e = (MODE == 0) ? __expf(tg[s] + bt) : __expf(bt - tg[s]) * tm[s];
                    o[j] = (s <= t) ? acc[j] * e : 0.f; }
                u32x2 w; w.x = pk2(o[0], o[1]); w.y = pk2(o[2], o[3]); *(LAS u32x2*)(sS + t * LS + s0) = w; }
        }
        LDS_BARRIER();
        if (c >= 1) WRITEOUT(c - 1);
        if (c >= 0) {
            LAS bf16_t* sCc = sC + cur * 80 * LS; LAS bf16_t* sCn = sC + (cur ^ 1) * 80 * LS;
#pragma unroll
            for (int i = 0; i < 2; ++i) { const int idx = wave + 8 * i, vtile = idx >> 2, ttile = idx & 3; const int t = ttile * 16 + r16;
                f32x4 a = {0.f, 0.f, 0.f, 0.f}; a = mma64(sCc + vtile * 16 * LS, sQ + ttile * 16 * LS, lane, a);
                const float dl = (MODE == 0) ? __expf(m_in - fmaxf(m_in, tm[t])) : __expf(tg[t]);
                a = a * dl;
#pragma unroll
                for (int kk = 0; kk < 2; ++kk) { const bf16x8 fa = tr_frag(sV, LSV, vtile, kk, lane); const bf16x8 fb = *(const LAS bf16x8*)(sS + (ttile * 16 + r16) * LS + kk * 32 + q4 * 8);
                    a = __builtin_amdgcn_mfma_f32_16x16x32_bf16(fa, fb, a, 0, 0, 0); }
                res[i] = a; }
            if (MODE == 0 && wave < 4) { const int t = wave * 16 + r16;
                f32x4 a = {0.f, 0.f, 0.f, 0.f}; a = mma64(sCc + 64 * LS, sQ + wave * 16 * LS, lane, a);
                a = a * __expf(m_in - fmaxf(m_in, tm[t]));
#pragma unroll
                for (int kk = 0; kk < 2; ++kk) { const bf16x8 fa = tr_frag(sV, LSV, 4, kk, lane); const bf16x8 fb = *(const LAS bf16x8*)(sS + (wave * 16 + r16) * LS + kk * 32 + q4 * 8);
                    a = __builtin_amdgcn_mfma_f32_16x16x32_bf16(fa, fb, a, 0, 0, 0); }
                if (q4 == 0) rden[t] = a[0]; }
#pragma unroll
            for (int i = 0; i < 2; ++i) { const int idx = wave + 8 * i, ktile = idx >> 2, vtile = idx & 3;
                f32x4 a = st[i] * decay;
#pragma unroll
                for (int kk = 0; kk < 2; ++kk) { const bf16x8 fa = tr_frag(sK, LS, ktile, kk, lane); const bf16x8 fb = tr_frag(sWV, LSV, vtile, kk, lane);
                    a = __builtin_amdgcn_mfma_f32_16x16x32_bf16(fa, fb, a, 0, 0, 0); }
                st[i] = a;
                u32x2 w; w.x = pk2(a[0], a[1]); w.y = pk2(a[2], a[3]); *(LAS u32x2*)(sCn + (vtile * 16 + r16) * LS + ktile * 16 + 4 * q4) = w; }
            if (MODE == 0 && wave >= 4) { const int ktile = wave - 4;
                f32x4 a = stx * decay;
#pragma unroll
                for (int kk = 0; kk < 2; ++kk) { const bf16x8 fa = tr_frag(sK, LS, ktile, kk, lane); const bf16x8 fb = tr_frag(sWV, LSV, 4, kk, lane);
                    a = __builtin_amdgcn_mfma_f32_16x16x32_bf16(fa, fb, a, 0, 0, 0); }
                stx = a;
                u32x2 w; w.x = pk2(a[0], a[1]); w.y = pk2(a[2], a[3]); *(LAS u32x2*)(sCn + (64 + r16) * LS + ktile * 16 + 4 * q4) = w; }
        }
        if (c + 1 < 36 && ((c + 1) & 1) == wpar) {
            const int cn = c + 1;
            LAS bf16_t* nQ = (LAS bf16_t*)On; LAS bf16_t* nK = (LAS bf16_t*)(On + 9216); LAS bf16_t* nV = (LAS bf16_t*)(On + 18432); LAS bf16_t* nWV = (LAS bf16_t*)(On + 29696);
            float om;
            if (MODE == 0) om = __expf(tabG[cn * 64 + lane] - fmaxf(m_out, tabM[cn * 64 + 63]));
            else om = __expf(tabG[cn * 64 + 63] - tabG[cn * 64 + lane]) * tabM[cn * 64 + lane];
            if (MODE == 0 && (wave >> 1) == 0) nWV[lane * LSV + 64] = (bf16_t)f2bf(om);
            *(LAS u32x4*)(nQ + lane * LS + w8) = r0; *(LAS u32x4*)(nQ + lane * LS + w8 + 8) = r3;
            *(LAS u32x4*)(nK + lane * LS + w8) = r1; *(LAS u32x4*)(nK + lane * LS + w8 + 8) = r4;
            *(LAS u32x4*)(nV + lane * LSV + w8) = r2; *(LAS u32x4*)(nV + lane * LSV + w8 + 8) = r5;
            { u32x4 wv; wv.x = pk2(bf_lo(r2.x) * om, bf_hi(r2.x) * om); wv.y = pk2(bf_lo(r2.y) * om, bf_hi(r2.y) * om); wv.z = pk2(bf_lo(r2.z) * om, bf_hi(r2.z) * om); wv.w = pk2(bf_lo(r2.w) * om, bf_hi(r2.w) * om);
              *(LAS u32x4*)(nWV + lane * LSV + w8) = wv;
              wv.x = pk2(bf_lo(r5.x) * om, bf_hi(r5.x) * om); wv.y = pk2(bf_lo(r5.y) * om, bf_hi(r5.y) * om); wv.z = pk2(bf_lo(r5.z) * om, bf_hi(r5.z) * om); wv.w = pk2(bf_lo(r5.w) * om, bf_hi(r5.w) * om);
              *(LAS u32x4*)(nWV + lane * LSV + w8 + 8) = wv; }
            if (c + 3 < 36) PREFETCH(c + 3);
        }
        LDS_BARRIER();
        if (c >= 0) {
            const bool isctx = c < 4; const int cc = isctx ? c : c - 4; const int Lseg = isctx ? CTXL : SEQL; const int base = isctx ? RL + b * CTXL : b * SEQL;
#pragma unroll
            for (int i = 0; i < 2; ++i) { const int idx = wave + 8 * i, vtile = idx >> 2, ttile = idx & 3; const int t = ttile * 16 + r16, v0 = vtile * 16 + 4 * q4;
                f32x4 a = res[i];
                if (MODE == 0) { const float mmt = fmaxf(m_in, tm[t]); const float dn = rden[t]; a = a * __builtin_amdgcn_rcpf(fmaxf(fabsf(dn), __expf(-(tb[t] + mmt)))); }
                else if (d == 0) {
#pragma unroll
                    for (int j = 0; j < 1; ++j) { const u32x2 xv = *(const LAS u32x2*)(sV + t * LSV + v0); a[0] += dskip * bf_lo(xv.x); a[1] += dskip * bf_hi(xv.x); a[2] += dskip * bf_lo(xv.y); a[3] += dskip * bf_hi(xv.y); } }
                u32x2 w; w.x = pk2(a[0], a[1]); w.y = pk2(a[2], a[3]);
                *(LAS u32x2*)(sO + t * LS + v0) = w; }
        }
        m_in = m_out;
    }
    LDS_BARRIER();
    WRITEOUT(35);
#undef WRITEOUT
#undef PREFETCH
}

__device__ __forceinline__ void rg_unit(const Params& p, LAS unsigned char* L, int l, int b, int n, int d) {
    const int tid = tid_opaque(), lane = tid & 63, wave = __builtin_amdgcn_readfirstlane(tid >> 6);
    const int tt = tid >> 3, cg8 = (tid & 7) * 8, r16 = lane & 15, q4 = lane >> 4;
    LAS bf16_t* sXb = (LAS bf16_t*)(L + 0); LAS bf16_t* sWt = (LAS bf16_t*)(L + 9216);
    LAS float* sXf = (LAS float*)(L + 27648); LAS float* sA = (LAS float*)(L + 44288); LAS float* sU = (LAS float*)(L + 60928); LAS float* sH = (LAS float*)(L + 77568);
    LAS float* sv = (LAS float*)(L + 95488);
    LAS float* sSeg = (LAS float*)(L + 96256);
    const bf16_t* CV = (const bf16_t*)(p.ws + WS_CV);
    bf16_t* outp = (bf16_t*)(p.ws + (d ? WS_RAWB : WS_XN));
    __syncthreads();
    for (int i = tid; i < 2 * 64 * 64; i += NTHREADS) { const int g = i >> 12, c = (i >> 6) & 63, dd = i & 63;
        const float v = p.in[I_WRG][((size_t)((((l * 2 + d) * 2 + g) * 4 + n) * 64 + c)) * 64 + dd]; sWt[(g * 64 + dd) * LS + c] = (bf16_t)f2bf(v); }
    if (tid < 64) { sv[tid] = p.in[I_BRG][((l * 2 + d) * 2 + 0) * 256 + n * 64 + tid]; sv[64 + tid] = p.in[I_BRG][((l * 2 + d) * 2 + 1) * 256 + n * 64 + tid];
        sv[128 + tid] = softplusf_(-p.in[I_LAM][(l * 2 + d) * 256 + n * 64 + tid]); }
    float hstate = 0.f;
    u32x4 rx = {0u, 0u, 0u, 0u};
    for (int c = -1; c < 36; ++c) {
        if (c >= 0) {
            float v[8] = {bf_lo(rx.x), bf_hi(rx.x), bf_lo(rx.y), bf_hi(rx.y), bf_lo(rx.z), bf_hi(rx.z), bf_lo(rx.w), bf_hi(rx.w)};
            *(LAS u32x4*)(sXb + tt * LS + cg8) = rx;
#pragma unroll
            for (int i = 0; i < 8; ++i) sXf[tt * 65 + cg8 + i] = v[i];
            LDS_BARRIER();
        }
        if (c + 1 < 36) {
            const int cn = c + 1; const bool isctx = cn < 4; const int cc = isctx ? cn : cn - 4; const int Lseg = isctx ? CTXL : SEQL;
            const int pos = cc * 64 + tt; const int pf = d ? Lseg - 1 - pos : pos;
            const int row = isctx ? RL + b * CTXL + pf : b * SEQL + (pf & 31) * 64 + (pf >> 5);
            rx = *(const u32x4*)(CV + (size_t)row * PALD + 1280 + n * 64 + cg8);
        }
        if (c >= 0) {
            { const int jt = wave & 3, dp = wave >> 2;
#pragma unroll
              for (int i = 0; i < 2; ++i) { const int dtile = 2 * dp + i;
                  f32x4 a0 = {0.f, 0.f, 0.f, 0.f}, a1 = {0.f, 0.f, 0.f, 0.f};
                  a0 = mma64(sXb + jt * 16 * LS, sWt + (dtile * 16) * LS, lane, a0);
                  a1 = mma64(sXb + jt * 16 * LS, sWt + (64 + dtile * 16) * LS, lane, a1);
                  const int dd = dtile * 16 + r16, j0 = jt * 16 + 4 * q4; const float br = sv[dd], bi = sv[64 + dd], sp = sv[128 + dd];
#pragma unroll
                  for (int jj = 0; jj < 4; ++jj) { const float rr = sigmoidf_(a0[jj] + br), ii = sigmoidf_(a1[jj] + bi); const float la = -8.f * rr * sp;
                      const float a = __expf(la); const float u = __builtin_amdgcn_sqrtf(fmaxf(1.f - a * a, 0.f)) * ii * sXf[(j0 + jj) * 65 + dd];
                      sA[(j0 + jj) * 65 + dd] = a; sU[(j0 + jj) * 65 + dd] = u; } } }
            LDS_BARRIER();
            { float pp[8], uu[8]; float P = 1.f, U = 0.f;
#pragma unroll
              for (int j = 0; j < 8; ++j) { const float a = sA[(wave * 8 + j) * 65 + lane], u = sU[(wave * 8 + j) * 65 + lane]; P = a * P; U = a * U + u; pp[j] = P; uu[j] = U; }
              sSeg[wave * 64 + lane] = P; sSeg[512 + wave * 64 + lane] = U;
              LDS_BARRIER();
              float h = hstate, hin = hstate;
#pragma unroll
              for (int s = 0; s < 8; ++s) { if (s == wave) hin = h; h = sSeg[s * 64 + lane] * h + sSeg[512 + s * 64 + lane]; }
              hstate = h;
#pragma unroll
              for (int j = 0; j < 8; ++j) sH[(wave * 8 + j) * 65 + lane] = pp[j] * hin + uu[j]; }
            LDS_BARRIER();
            { const bool isctx = c < 4; const int cc = isctx ? c : c - 4; const int Lseg = isctx ? CTXL : SEQL;
              const int pos = cc * 64 + tt; const int pf = d ? Lseg - 1 - pos : pos;
              const int row = isctx ? RL + b * CTXL + pf : b * SEQL + (pf & 31) * 64 + (pf >> 5);
              const LAS float* hp = sH + tt * 65 + cg8;
              u32x4 w; w.x = pk2(hp[0], hp[1]); w.y = pk2(hp[2], hp[3]); w.z = pk2(hp[4], hp[5]); w.w = pk2(hp[6], hp[7]);
              st16_wt(outp + (size_t)row * D + 768 + n * 64 + cg8, w); }
        }
    }
}
__device__ __forceinline__ void scan_phase(const Params& p, LAS unsigned char* L, int l) {
    for (int u = blockIdx.x; u < 256; u += gridDim.x) {
        if (u < 64) seq_unit<0>(p, L, l, u >> 3, (u & 7) >> 1, u & 1);
        else if (u < 192) { const int v = u - 64; seq_unit<1>(p, L, l, v >> 4, (v & 15) >> 1, v & 1); }
        else { const int v = u - 192; rg_unit(p, L, l, v >> 3, (v & 7) >> 1, v & 1); }
    }
}

__global__ void __launch_bounds__(NTHREADS, 2) fwd_kernel(Params p) {
    extern __shared__ __attribute__((aligned(16))) unsigned char lds_raw[];
    LAS unsigned char* L = (LAS unsigned char*)lds_raw;
    if (threadIdx.x < 4) ((LAS unsigned*)(L + LDS_BARST))[threadIdx.x] = 0u;
    __syncthreads();
    (void)xcd_barrier_post((unsigned*)(p.ws + WS_CTL), (volatile LAS unsigned*)(L + LDS_BARST));
#pragma unroll 1
    for (int ph = p.lo; ph < p.hi; ++ph) {
        Params pl = p; { unsigned char* w_ = pl.ws; asm volatile("" : "+s"(w_)); pl.ws = w_; }
        if (ph == 0) phase0(pl, L);
        else if (ph == NPHASES - 1) final_phase(pl);
        else {
            const int l = (ph - 1) / 10, k = (ph - 1) - 10 * l;
            if (k == 9 && l == 1) continue;
            if (k == 0) normmod_phase(pl, l, 0);
            else if (k == 6) normmod_phase(pl, l, 1);
            else if (k == 2) conv_phase(pl, L, l);
            else if (k == 3) scan_phase(pl, L, l);
            else if (k == 4) finalize_phase(pl, l, l == 0 ? RT : RL);
            else {
                const unsigned char* wt = pl.ws + WS_WT + (size_t)l * WT_LAYER;
                const int Mrest = l == 0 ? RT : RL;
                pg8::Gemm g; EpiAll E; E.pp = &pl; E.l = l; Order S; S.nslice = 0;
                if (k == 1)      { g.A = (const pg8::bf16_t*)(pl.ws + WS_XN); g.Bt = (const pg8::bf16_t*)wt;            g.M = RT;    g.N = PINP; g.K = D;  g.ld = D;  E.kind = 0; }
                else if (k == 5) { g.A = (const pg8::bf16_t*)(pl.ws + WS_XN); g.Bt = (const pg8::bf16_t*)(wt + WT_OUT); g.M = Mrest; g.N = D;    g.K = D;  g.ld = D;  E.kind = 1; }
                else if (k == 7) { g.A = (const pg8::bf16_t*)(pl.ws + WS_XN); g.Bt = (const pg8::bf16_t*)(wt + WT_W1);  g.M = Mrest; g.N = FF;   g.K = D;  g.ld = D;  E.kind = 2; }
                else if (k == 8) { g.A = (const pg8::bf16_t*)(pl.ws + WS_H);  g.Bt = (const pg8::bf16_t*)(wt + WT_W2);  g.M = RL;    g.N = D;    g.K = FF; g.ld = FF; E.kind = 3; }
                else             { g.A = (const pg8::bf16_t*)(pl.ws + WS_H) + (size_t)RL * FF; g.Bt = (const pg8::bf16_t*)(wt + WT_W2); g.M = RC; g.N = D; g.K = FF / 8; g.ld = FF; E.kind = 4; S.nslice = 8; }
                S.so.init(g.M, g.N, (int)gridDim.x, (int)blockIdx.x);
                pg8::gemm_phase<EpiAll, Order, true, true>(L, g, S, E);
            }
        }
        if (ph + 1 < p.hi) { XcdBarrier bar; bar.bar = (unsigned*)(pl.ws + WS_CTL); bar.x = xb_xcc_id(); bar.st = (volatile LAS unsigned*)(L + LDS_BARST); xcd_barrier(bar); }
    }
}

extern "C" void kernel_launch(void* const* d_in, const int* in_sizes, int n_in, void* d_out, int out_size, void* d_ws, size_t ws_size, hipStream_t stream) {
    static int grid = 0;
    if (grid == 0) {
        if (n_in != 31 || out_size != RL * D || ws_size < WS_END) { fprintf(stderr, "kernel_launch: unexpected problem (n_in %d out %d ws %zu)\n", n_in, out_size, ws_size); grid = -1; return; }
        int dev = 0, cus = 0, per_cu = 0;
        (void)hipGetDevice(&dev); (void)hipDeviceGetAttribute(&cus, hipDeviceAttributeMultiprocessorCount, dev);
        if (hipFuncSetAttribute((const void*)fwd_kernel, hipFuncAttributeMaxDynamicSharedMemorySize, LDS_BYTES) != hipSuccess) { fprintf(stderr, "kernel_launch: hipFuncSetAttribute failed\n"); grid = -1; return; }
        if (hipOccupancyMaxActiveBlocksPerMultiprocessor(&per_cu, (const void*)fwd_kernel, NTHREADS, LDS_BYTES) != hipSuccess || per_cu < 1) { fprintf(stderr, "kernel_launch: occupancy query says %d\n", per_cu); per_cu = 1; }
        (void)hipGetLastError();
        if (per_cu > 1) per_cu = 1;
        grid = cus * per_cu;
        if (grid > 256) grid = 256;
    }
    if (grid < 0) return;
    Params p{};
    for (int i = 0; i < 31; ++i) p.in[i] = (const float*)d_in[i];
    p.out = (float*)d_out; p.ws = (unsigned char*)d_ws;
    (void)hipMemsetAsync((unsigned char*)d_ws + WS_CTL, 0, CTL_BYTES, stream);
#if MK_N_LAUNCHES == 1
    p.lo = 0; p.hi = NPHASES;
    hipLaunchKernelGGL(fwd_kernel, dim3(grid), dim3(NTHREADS), LDS_BYTES, stream, p);
    hipError_t e = hipPeekAtLastError();
    if (e != hipSuccess) fprintf(stderr, "launch failed: %s (grid %d)\n", hipGetErrorString(e), grid);
#else
    for (int k = 0; k < NPHASES; ++k) { p.lo = k; p.hi = k + 1; hipLaunchKernelGGL(fwd_kernel, dim3(grid), dim3(NTHREADS), LDS_BYTES, stream, p); }
#endif
}
```

```cpp
#include <hip/hip_runtime.h>
#include <hip/hip_cooperative_groups.h>
#include <cstdio>
#include <cstdint>
namespace cg = cooperative_groups;
__device__ __forceinline__ int tid_opaque() { int t = threadIdx.x; asm volatile("" : "+v"(t)); return t; }
namespace pg8 {
#define PG8_LAS __attribute__((address_space(3)))
typedef unsigned short bf16_t;
typedef short bf16x8 __attribute__((ext_vector_type(8)));
typedef float f32x4 __attribute__((ext_vector_type(4)));
typedef unsigned u32x4 __attribute__((ext_vector_type(4)));
constexpr int BM = 256, BK = 64, HALF = 128, HTB = HALF * BK * 2  , STAGE_BYTES = 8 * HTB, NXCD = 8, WGM = 8;

__host__ __device__ __forceinline__ int lds_byte(int r, int c) { const int st = (r >> 4) * 2 + (c >> 5), rr = r & 15, cc = c & 31, ob = rr * 64 + cc * 2; return st * 1024 + (ob ^ (((ob >> 9) & 1) << 5)); }
__host__ __device__ __forceinline__ void stage_rc(int b, int& R, int& C) { const int st = b / 1024, sb = b % 1024, swz = sb ^ (((sb >> 9) & 1) << 5); R = (st >> 1) * 16 + swz / 64; C = (st & 1) * 32 + (swz % 64) / 2; }
__host__ __device__ __forceinline__ int perm32(int rho) { const int n = rho >> 4, i = rho & 15; return 8 * (i >> 2) + 4 * n + (i & 3); }

struct Unit { int pm, pn, ks; };
struct Gemm { const bf16_t* A; const bf16_t* Bt; int M, N, K, ld; };

struct StaticOrder {
    int nM, nN, nwg, G, c;
    __host__ __device__ void init(int M, int N, int G_, int c_) { nM = M / BM; nN = N / BM; nwg = nM * nN; G = G_; c = c_; }
    __host__ __device__ bool next(int i, Unit& u) const {
        const long L = (long)i * G + c; if (L >= nwg) return false;
        int wgid = (int)L; { const int q = nwg / NXCD, r = nwg % NXCD, xcd = wgid % NXCD, off = wgid / NXCD; wgid = (xcd < r ? xcd * (q + 1) : r * (q + 1) + (xcd - r) * q) + off; }
        const int nig = WGM * nN, gid = wgid / nig, fm = gid * WGM, gsz = (nM - fm) < WGM ? (nM - fm) : WGM;
        u.pm = fm + ((wgid % nig) % gsz); u.pn = (wgid % nig) / gsz; u.ks = 0; return true;
    }
    __device__ __forceinline__ void a_ready(const Unit&) const {}
    __device__ __forceinline__ void done(const Unit&) const {}
};

__device__ __forceinline__ unsigned cvt_pk_bf16(float lo, float hi) { unsigned r; asm volatile("v_cvt_pk_bf16_f32 %0, %1, %2" : "=v"(r) : "v"(lo), "v"(hi)); return r; }
typedef float f32x2 __attribute__((ext_vector_type(2)));
template <class Epi, class Sched, bool ALIGN_EPI = false, bool SP2 = false>
__device__ __forceinline__ void gemm_phase(PG8_LAS unsigned char* lds, const Gemm g, const Sched& S, const Epi& E) {
    const int tid = tid_opaque(), wid = __builtin_amdgcn_readfirstlane(tid >> 6), lane = tid & 63, wr = wid >> 2, wc = wid & 3, fr = lane & 15, fq = lane >> 4;
    const int K = g.K, nt = K / BK, ld = g.ld;
    unsigned voffA[2], voffB[2];
#pragma unroll
    for (int i = 0; i < 2; ++i) { int R, C; stage_rc(tid * 16 + i * 8192, R, C); const int Rb = Epi::PERM ? ((R & ~31) + perm32(R & 31)) : R;
        voffA[i] = (unsigned)(R * ld + C) * 2u; voffB[i] = (unsigned)(Rb * ld + C) * 2u; }
    const size_t kstep = (size_t)(BK * 2);
    const size_t hstep = (size_t)HALF * ld * 2;
    const size_t tstep = 2 * hstep;
    const unsigned ldsw = (unsigned)wid * 1024u;
    const int aoff = lds_byte(wr * 64 + fr, fq * 8), boff = lds_byte(wc * 32 + fr, fq * 8);
#define PG8_SA(b, h) (((b) * 2 + (h)) * HTB)
#define PG8_SB(b, h) ((4 + (b) * 2 + (h)) * HTB)
#define PG8_STAGE(bufoff, gbase, voff) do { _Pragma("unroll") for (int _i = 0; _i < 2; ++_i) \
        __builtin_amdgcn_global_load_lds((const unsigned*)((const char*)(gbase) + (voff)[_i]), (PG8_LAS unsigned*)(lds + (bufoff) + ldsw + _i * 8192), 16, 0, 0); } while (0)
#define PG8_LDA(dst, b, h) do { _Pragma("unroll") for (int m = 0; m < 4; ++m) _Pragma("unroll") for (int k = 0; k < 2; ++k) dst[m][k] = *(const PG8_LAS bf16x8*)(lds + PG8_SA(b, h) + aoff + m * 2048 + k * 1024); } while (0)
#define PG8_LDB(dst, b, h) do { _Pragma("unroll") for (int n = 0; n < 2; ++n) _Pragma("unroll") for (int k = 0; k < 2; ++k) dst[n][k] = *(const PG8_LAS bf16x8*)(lds + PG8_SB(b, h) + boff + n * 2048 + k * 1024); } while (0)
#define PG8_MMA(ai, bj, At, Bt) do { __builtin_amdgcn_s_setprio(1); _Pragma("unroll") for (int m = 0; m < 4; ++m) _Pragma("unroll") for (int n = 0; n < 2; ++n) _Pragma("unroll") for (int k = 0; k < 2; ++k) \
        acc[ai][bj][m][n] = __builtin_amdgcn_mfma_f32_16x16x32_bf16(Bt[n][k], At[m][k], acc[ai][bj][m][n], 0, 0, 0); __builtin_amdgcn_s_setprio(0); } while (0)
#define PG8_WAIT_V(n) asm volatile("s_waitcnt vmcnt(" #n ")" ::: "memory")
#define PG8_WAIT_L(n) asm volatile("s_waitcnt lgkmcnt(" #n ")" ::: "memory")
#define PG8_BAR __builtin_amdgcn_s_barrier()
#define PG8_SCHED __builtin_amdgcn_sched_barrier(0)
    Unit cur, nxt; int ui = 0;
    if (!S.next(0, cur)) return;
    f32x4 acc[2][2][4][2];
#pragma unroll
    for (int a = 0; a < 2; ++a)
#pragma unroll
        for (int b = 0; b < 2; ++b)
#pragma unroll
            for (int m = 0; m < 4; ++m)
#pragma unroll
                for (int n = 0; n < 2; ++n) acc[a][b][m][n] = (f32x4){0.f, 0.f, 0.f, 0.f};
    bf16x8 At[4][2], B0[2][2], B1[2][2];
    const size_t sstep = (size_t)K * 2;
    const char* cA = (const char*)g.A + (size_t)cur.pm * tstep + (size_t)cur.ks * sstep; const char* cB = (const char*)g.Bt + (size_t)cur.pn * tstep + (size_t)cur.ks * sstep;
    S.a_ready(cur);
    if constexpr (SP2) {
        PG8_STAGE(PG8_SB(0, 0), cB, voffB); PG8_STAGE(PG8_SB(0, 1), cB + hstep, voffB); PG8_STAGE(PG8_SA(0, 0), cA, voffA); PG8_STAGE(PG8_SA(0, 1), cA + hstep, voffA);
        if (wr == 1) PG8_BAR;
        PG8_WAIT_V(2); PG8_BAR;
        PG8_STAGE(PG8_SB(1, 0), cB + kstep, voffB); PG8_STAGE(PG8_SA(1, 0), cA + kstep, voffA); PG8_STAGE(PG8_SB(1, 1), cB + hstep + kstep, voffB);
        PG8_WAIT_V(6); PG8_BAR;
    } else {
        PG8_STAGE(PG8_SB(0, 0), cB, voffB); PG8_STAGE(PG8_SA(0, 0), cA, voffA); PG8_STAGE(PG8_SB(0, 1), cB + hstep, voffB); PG8_STAGE(PG8_SA(0, 1), cA + hstep, voffA);
        if (wr == 1) PG8_BAR;
        PG8_WAIT_V(4); PG8_BAR;
        PG8_STAGE(PG8_SB(1, 0), cB + kstep, voffB); PG8_STAGE(PG8_SA(1, 0), cA + kstep, voffA); PG8_STAGE(PG8_SB(1, 1), cB + hstep + kstep, voffB);
        PG8_WAIT_V(6); PG8_BAR;
    }
    for (;;) {
        const bool has_next = S.next(ui + 1, nxt);
        const char* nA = has_next ? (const char*)g.A + (size_t)nxt.pm * tstep + (size_t)nxt.ks * sstep : cA; const char* nB = has_next ? (const char*)g.Bt + (size_t)nxt.pn * tstep + (size_t)nxt.ks * sstep : cB;
        for (int t = 0; t < nt; t += 2) {
            const bool last = (t == nt - 2);
            const char* a1 = cA + (size_t)(t + 1) * kstep;
            const char* a2 = last ? nA : cA + (size_t)(t + 2) * kstep; const char* b2 = last ? nB : cB + (size_t)(t + 2) * kstep;
            const char* a3 = a2 + kstep; const char* b3 = b2 + kstep;
            if (last && has_next) S.a_ready(nxt);
            if constexpr (SP2) {
            PG8_LDB(B0, 0, 0); PG8_LDB(B1, 0, 1); PG8_SCHED; PG8_LDA(At, 0, 0); PG8_STAGE(PG8_SA(1, 1), a1 + hstep, voffA);
            PG8_WAIT_V(8); PG8_WAIT_L(0); PG8_BAR; PG8_MMA(0, 0, At, B0); PG8_MMA(0, 1, At, B1); PG8_BAR; PG8_SCHED;
            PG8_LDA(At, 0, 1); PG8_STAGE(PG8_SB(0, 0), b2, voffB); PG8_STAGE(PG8_SB(0, 1), b2 + hstep, voffB); PG8_STAGE(PG8_SA(0, 0), a2, voffA);
            PG8_WAIT_V(8); PG8_WAIT_L(0); PG8_BAR; PG8_MMA(1, 0, At, B0); PG8_MMA(1, 1, At, B1); PG8_BAR; PG8_SCHED;
            PG8_LDB(B0, 1, 0); PG8_LDB(B1, 1, 1); PG8_SCHED; PG8_LDA(At, 1, 0); PG8_STAGE(PG8_SA(0, 1), a2 + hstep, voffA);
            PG8_WAIT_V(8); PG8_WAIT_L(0); PG8_BAR; PG8_MMA(0, 0, At, B0); PG8_MMA(0, 1, At, B1); PG8_BAR; PG8_SCHED;
            PG8_LDA(At, 1, 1); PG8_STAGE(PG8_SB(1, 0), b3, voffB); PG8_STAGE(PG8_SB(1, 1), b3 + hstep, voffB); PG8_STAGE(PG8_SA(1, 0), a3, voffA);
            PG8_WAIT_V(8); PG8_WAIT_L(0); PG8_BAR; PG8_MMA(1, 0, At, B0); PG8_MMA(1, 1, At, B1); PG8_BAR; PG8_SCHED;
            } else {
            PG8_LDB(B0, 0, 0); PG8_SCHED; PG8_LDA(At, 0, 0); PG8_STAGE(PG8_SA(1, 1), a1 + hstep, voffA);
            PG8_WAIT_L(8); PG8_BAR; PG8_WAIT_L(0); PG8_MMA(0, 0, At, B0); PG8_BAR; PG8_SCHED;
            PG8_LDB(B1, 0, 1); PG8_STAGE(PG8_SB(0, 0), b2, voffB);
            PG8_BAR; PG8_WAIT_L(0); PG8_MMA(0, 1, At, B1); PG8_BAR;
            PG8_LDA(At, 0, 1); PG8_STAGE(PG8_SA(0, 0), a2, voffA);
            PG8_BAR; PG8_WAIT_L(0); PG8_MMA(1, 0, At, B0); PG8_BAR; PG8_SCHED;
            PG8_STAGE(PG8_SB(0, 1), b2 + hstep, voffB);
            PG8_WAIT_V(6); PG8_BAR; PG8_MMA(1, 1, At, B1); PG8_BAR;
            PG8_LDB(B0, 1, 0); PG8_SCHED; PG8_LDA(At, 1, 0); PG8_STAGE(PG8_SA(0, 1), a2 + hstep, voffA);
            PG8_WAIT_L(8); PG8_BAR; PG8_WAIT_L(0); PG8_MMA(0, 0, At, B0); PG8_BAR; PG8_SCHED;
            PG8_LDB(B1, 1, 1); PG8_STAGE(PG8_SB(1, 0), b3, voffB);
            PG8_BAR; PG8_WAIT_L(0); PG8_MMA(0, 1, At, B1); PG8_BAR;
            PG8_LDA(At, 1, 1); PG8_STAGE(PG8_SA(1, 0), a3, voffA);
            PG8_BAR; PG8_WAIT_L(0); PG8_MMA(1, 0, At, B0); PG8_BAR; PG8_SCHED;
            PG8_STAGE(PG8_SB(1, 1), b3 + hstep, voffB);
            PG8_WAIT_V(6); PG8_BAR; PG8_MMA(1, 1, At, B1); PG8_BAR;
            }
        }
        if constexpr (ALIGN_EPI) { if (wr == 0) PG8_BAR; }
        if constexpr (!Epi::AFTER_DRAIN) { E(acc, cur, wr, wc, fr, fq); S.done(cur); }
        if (!has_next) break;
#pragma unroll
        for (int a = 0; a < 2; ++a)
#pragma unroll
            for (int b = 0; b < 2; ++b)
#pragma unroll
                for (int m = 0; m < 4; ++m)
#pragma unroll
                    for (int n = 0; n < 2; ++n) acc[a][b][m][n] = (f32x4){0.f, 0.f, 0.f, 0.f};
        cur = nxt; cA = nA; cB = nB; ++ui;
        if constexpr (ALIGN_EPI) { if (wr == 1) PG8_BAR; }
    }
    PG8_WAIT_V(0);
    if constexpr (!ALIGN_EPI) { if (wr == 0) PG8_BAR; }
    PG8_BAR;
    if constexpr (Epi::AFTER_DRAIN) { E.fused(acc, cur, wr, wc, fr, fq, lds, wid, lane); S.done(cur); }
#undef PG8_SA
#undef PG8_SB
#undef PG8_STAGE
#undef PG8_LDA
#undef PG8_LDB
#undef PG8_MMA
#undef PG8_WAIT_V
#undef PG8_WAIT_L
#undef PG8_BAR
#undef PG8_SCHED
}
}

#ifndef MK_N_LAUNCHES
#define MK_N_LAUNCHES 1
#endif

#define LAS __attribute__((address_space(3)))
typedef unsigned short bf16_t;
typedef unsigned u32x4 __attribute__((ext_vector_type(4)));
typedef unsigned u32x2 __attribute__((ext_vector_type(2)));
typedef float f32x4 __attribute__((ext_vector_type(4)));
typedef float f32x2 __attribute__((ext_vector_type(2)));
typedef short bf16x8 __attribute__((ext_vector_type(8)));

constexpr int D = 1024, NBATCH = 8, SEQL = 2048, CTXL = 256;
constexpr int RL = NBATCH * SEQL;
constexpr int RC = NBATCH * CTXL;
constexpr int RT = RL + RC;
constexpr int PIN = 2848, PINP = 3072, PALD = 1536, PRLD = 1280, FF = 4096;
constexpr float EPS = 1e-6f;
constexpr int NTHREADS = 512, NWAVES = 8;
constexpr int LDS_BYTES = 163840;
constexpr int LDS_BARST = LDS_BYTES - 16;
constexpr int NPHASES = 22;

constexpr size_t MiB = 1u << 20;
constexpr size_t WS_WT = 0;
constexpr size_t WT_LAYER = 24 * MiB, WT_OUT = 6 * MiB, WT_W1 = 8 * MiB, WT_W2 = 16 * MiB;
constexpr size_t WS_XN = 48 * MiB;
constexpr size_t WS_PA = 84 * MiB;
constexpr size_t WS_PR = 138 * MiB;
constexpr size_t WS_CV = 183 * MiB;
constexpr size_t WS_RAWB = 84 * MiB;
constexpr size_t WS_H = 84 * MiB;
constexpr size_t WS_CTXRES = 237 * MiB;
constexpr size_t WS_GATES = 245 * MiB;
constexpr size_t WS_MOD = 248 * MiB;
constexpr size_t WS_CTL = 249 * MiB;
constexpr size_t CTL_BYTES = 16384;
constexpr size_t WS_PART = WS_H;
constexpr size_t WS_END = 250 * MiB;

struct Params { const float* in[31]; float* out; unsigned char* ws; int lo, hi; };

enum { I_X = 0, I_C, I_CTX, I_CCTX, I_WADA, I_BADA, I_GMIX, I_WIN, I_CAW, I_CAB, I_BIG, I_BFG, I_GHA, I_CBW, I_CBB, I_DTB, I_ALOG, I_DSKIP, I_GNB,
       I_CCW, I_CCB, I_WRG, I_BRG, I_LAM, I_WOUT, I_GMLP, I_W1, I_B1, I_W2, I_B2, I_GFIN };

__device__ __forceinline__ unsigned f2bf(float f) { unsigned u = __builtin_bit_cast(unsigned, f); return (u + 0x7fffu + ((u >> 16) & 1u)) >> 16; }
typedef __bf16 bf16x2_t __attribute__((ext_vector_type(2)));
__device__ __forceinline__ unsigned pk2(float lo, float hi) { const f32x2 v = {lo, hi}; const bf16x2_t b = __builtin_convertvector(v, bf16x2_t); return __builtin_bit_cast(unsigned, b); }
__device__ __forceinline__ float bf_lo(unsigned u) { return __builtin_bit_cast(float, u << 16); }
__device__ __forceinline__ float bf_hi(unsigned u) { return __builtin_bit_cast(float, u & 0xffff0000u); }
__device__ __forceinline__ float bf1(unsigned short h) { return __builtin_bit_cast(float, ((unsigned)h) << 16); }
__device__ __forceinline__ float wave_sum(float v) {
#pragma unroll
    for (int o = 1; o < 64; o <<= 1) v += __shfl_xor(v, o);
    return v;
}
__device__ __forceinline__ float sigmoidf_(float x) { return __builtin_amdgcn_rcpf(1.f + __expf(-x)); }
__device__ __forceinline__ float siluf_(float x) { return x * __builtin_amdgcn_rcpf(1.f + __expf(-x)); }
__device__ __forceinline__ float softplusf_(float x) { return fmaxf(x, 0.f) + log1pf(__expf(-fabsf(x))); }
__device__ __forceinline__ float gelu_tanh(float x) { const float u = 0.7978845608028654f * (x + 0.044715f * x * x * x); const float e = __expf(2.f * u); const float th = 1.f - 2.f / (e + 1.f); return 0.5f * x * (1.f + th); }

__device__ __forceinline__ void st16_wt(void* ptr, u32x4 v) { asm volatile("global_store_dwordx4 %0, %1, off sc1\n\ts_nop 1" :: "v"(ptr), "v"(v) : "memory"); }
__device__ __forceinline__ void st16_wt(void* ptr, f32x4 v) { asm volatile("global_store_dwordx4 %0, %1, off sc1\n\ts_nop 1" :: "v"(ptr), "v"(v) : "memory"); }
__device__ __forceinline__ void st8_wt(void* ptr, u32x2 v) { __hip_atomic_store((unsigned long long*)ptr, __builtin_bit_cast(unsigned long long, v), __ATOMIC_RELAXED, __HIP_MEMORY_SCOPE_AGENT); }
__device__ __forceinline__ void st4_wt(float* ptr, float v) { __hip_atomic_store(ptr, v, __ATOMIC_RELAXED, __HIP_MEMORY_SCOPE_AGENT); }
#define LDS_BARRIER() asm volatile("s_waitcnt lgkmcnt(0)\n\ts_barrier" ::: "memory")
constexpr int LS = 72;
__device__ __forceinline__ f32x4 mma64(const LAS bf16_t* A, const LAS bf16_t* Bt, int lane, f32x4 acc) {
    const int r = lane & 15, q = lane >> 4;
#pragma unroll
    for (int kk = 0; kk < 2; ++kk) {
        const bf16x8 a = *(const LAS bf16x8*)(A + r * LS + kk * 32 + q * 8);
        const bf16x8 b = *(const LAS bf16x8*)(Bt + r * LS + kk * 32 + q * 8);
        acc = __builtin_amdgcn_mfma_f32_16x16x32_bf16(a, b, acc, 0, 0, 0);
    }
    return acc;
}

typedef short v4i16_t __attribute__((ext_vector_type(4)));
__device__ __forceinline__ bf16x8 tr_frag(const LAS bf16_t* T, int ld, int ctile, int kk, int lane) {
    const int g = lane >> 4, q = (lane & 15) >> 2, pp = lane & 3;
    const LAS bf16_t* a0 = T + (32 * kk + 8 * g + q) * ld + 16 * ctile + 4 * pp;
    const v4i16_t lo = __builtin_amdgcn_ds_read_tr16_b64_v4i16((LAS v4i16_t*)a0), hi = __builtin_amdgcn_ds_read_tr16_b64_v4i16((LAS v4i16_t*)(a0 + 4 * ld));
    return (bf16x8){lo.x, lo.y, lo.z, lo.w, hi.x, hi.y, hi.z, hi.w};
}
#define XB_TMO      128
#define XB_XCNT(j)  (256  + 64 * (j))
#define XB_XSUB(j)  (1280 + 64 * (j))
#define XB_XGEN(j)  (2304 + 64 * (j))
#define XB_TOP      3328
#define XB_TOPGEN   3392
#define XCD_BAR_WORDS 3456
#define XB_SPIN_CAP (1u << 18)

__device__ __forceinline__ unsigned xb_ld(unsigned* p)              { return __hip_atomic_load(p, __ATOMIC_RELAXED, __HIP_MEMORY_SCOPE_AGENT); }
__device__ __forceinline__ unsigned xb_add(unsigned* p, unsigned v) { return __hip_atomic_fetch_add(p, v, __ATOMIC_RELAXED, __HIP_MEMORY_SCOPE_AGENT); }
__device__ __forceinline__ unsigned xb_xcc_id() { return (unsigned)__builtin_amdgcn_s_getreg((3 << 11) | 20) & 0xFu; }
#define XB_SPIN(cond, bar) do { unsigned _sp = 0; while (cond) { __builtin_amdgcn_s_sleep(1); \
    if ((++_sp & 255u) == 0u) { if (xb_ld(&(bar)[XB_TMO])) break; if (_sp > XB_SPIN_CAP) { atomicAdd(&(bar)[XB_TMO], 1u); break; } } } } while (0)

struct XcdBarrier {
    unsigned* bar; unsigned x;
    volatile LAS unsigned* st;
};

__device__ __forceinline__ XcdBarrier xcd_barrier_post(unsigned* bar, volatile LAS unsigned* st) {
    XcdBarrier b; b.bar = bar; b.x = xb_xcc_id(); b.st = st;
    if (threadIdx.x == 0) (void)xb_add(&bar[XB_XCNT(b.x)], 1u);
    return b;
}
__device__ __forceinline__ void xcd_barrier_complete(unsigned* bar, unsigned x, unsigned& nloc, unsigned& nx) {
    const unsigned G = gridDim.x * gridDim.y * gridDim.z;
    unsigned sum, cnt, mine, sp = 0u;
    for (;;) {
        sum = 0u; cnt = 0u; mine = 0u;
#pragma unroll
        for (unsigned j = 0; j < 16; ++j) { const unsigned c = xb_ld(&bar[XB_XCNT(j)]); sum += c; cnt += (c > 0u) ? 1u : 0u; mine = (j == x) ? c : mine; }
        if (sum == G) break;
        __builtin_amdgcn_s_sleep(1);
        if ((++sp & 255u) == 0u) { if (xb_ld(&bar[XB_TMO])) break; if (sp > XB_SPIN_CAP) { atomicAdd(&bar[XB_TMO], 1u); break; } }
    }
    nloc = mine > 0u ? mine : 1u; nx = cnt > 0u ? cnt : 1u;
}

__device__ __forceinline__ void xcd_barrier(const XcdBarrier& b) {
    asm volatile("s_waitcnt vmcnt(0)" ::: "memory");
    __syncthreads();
    if (threadIdx.x == 0) {
        unsigned* bar = b.bar;
        __builtin_amdgcn_s_waitcnt(0);
        unsigned nloc = b.st[0], nx = b.st[1];
        if (nloc == 0u) { xcd_barrier_complete(bar, b.x, nloc, nx); b.st[0] = nloc; b.st[1] = nx; }
        const unsigned old = xb_add(&bar[XB_XSUB(b.x)], 1u);
        const unsigned gen = old / nloc;
        if (old + 1u == (gen + 1u) * nloc) {
            __builtin_amdgcn_fence(__ATOMIC_RELEASE, "agent");
            asm volatile("s_waitcnt vmcnt(0)" ::: "memory");
            const unsigned og = xb_add(&bar[XB_TOP], 1u);
            const unsigned tg = og / nx;
            if (og + 1u == (tg + 1u) * nx) xb_add(&bar[XB_TOPGEN], 1u);
            else XB_SPIN(xb_ld(&bar[XB_TOPGEN]) == tg, bar);
            __builtin_amdgcn_fence(__ATOMIC_ACQUIRE, "agent");
            xb_add(&bar[XB_XGEN(b.x)], 1u);
            asm volatile("s_waitcnt vmcnt(0)" ::: "memory");
        } else {
            XB_SPIN(xb_ld(&bar[XB_XGEN(b.x)]) == gen, bar);
            __builtin_amdgcn_fence(__ATOMIC_ACQUIRE, "agent");
            asm volatile("s_waitcnt vmcnt(0)" ::: "memory");
        }
    }
    __syncthreads();
}

struct EpiAll {
    static constexpr bool PERM = true, AFTER_DRAIN = false;
    const Params* pp; int kind, l;
    __device__ __forceinline__ void operator()(const pg8::f32x4 (&acc)[2][2][4][2], const pg8::Unit& u, int wr, int wc, int fr, int fq) const {
        const Params& p = *pp;
        if (kind == 0) {
            const int row0 = u.pm * 256 + wr * 64 + fr;
            if (u.pn < 11) {
                const bool pa = u.pn < 6; const int ld = pa ? PALD : PRLD;
                bf16_t* P = (bf16_t*)(p.ws + (pa ? WS_PA : WS_PR));
                const int col0 = (pa ? u.pn : u.pn - 6) * 256 + wc * 32 + 8 * fq;
#pragma unroll
                for (int ai = 0; ai < 2; ++ai)
#pragma unroll
                    for (int m = 0; m < 4; ++m) { bf16_t* rowp = P + (size_t)(row0 + ai * 128 + m * 16) * ld + col0;
#pragma unroll
                        for (int bj = 0; bj < 2; ++bj) { const pg8::f32x4 v0 = acc[ai][bj][m][0], v1 = acc[ai][bj][m][1];
                            u32x4 w; w.x = pg8::cvt_pk_bf16(v0[0], v0[1]); w.y = pg8::cvt_pk_bf16(v0[2], v0[3]); w.z = pg8::cvt_pk_bf16(v1[0], v1[1]); w.w = pg8::cvt_pk_bf16(v1[2], v1[3]);
                            st16_wt(rowp + bj * 128, w); } }
            } else if (wc == 0) {
                float* gates = (float*)(p.ws + WS_GATES);
#pragma unroll
                for (int ai = 0; ai < 2; ++ai)
#pragma unroll
                    for (int m = 0; m < 4; ++m) { float* gp = gates + (size_t)(row0 + ai * 128 + m * 16) * 32 + 8 * fq;
                        st16_wt(gp, acc[ai][0][m][0]); st16_wt(gp + 4, acc[ai][0][m][1]); }
            }
        } else if (kind == 4) {
            bf16_t* part = (bf16_t*)(p.ws + WS_PART) + (size_t)u.ks * RC * D;
            const int row0 = u.pm * 256 + wr * 64 + fr; const int col0 = u.pn * 256 + wc * 32 + 8 * fq;
#pragma unroll
            for (int bj = 0; bj < 2; ++bj)
#pragma unroll
                for (int ai = 0; ai < 2; ++ai)
#pragma unroll
                    for (int m = 0; m < 4; ++m) { const pg8::f32x4 v0 = acc[ai][bj][m][0], v1 = acc[ai][bj][m][1];
                        u32x4 w; w.x = pk2(v0[0], v0[1]); w.y = pk2(v0[2], v0[3]); w.z = pk2(v1[0], v1[1]); w.w = pk2(v1[2], v1[3]);
                        st16_wt(part + (size_t)(row0 + ai * 128 + m * 16) * D + col0 + bj * 128, w); }
        } else if (kind == 2) {
            bf16_t* H = (bf16_t*)(p.ws + WS_H); const float* b1 = p.in[I_B1] + l * FF;
            const int row0 = u.pm * 256 + wr * 64 + fr; const int col0 = u.pn * 256 + wc * 32 + 8 * fq;
#pragma unroll
            for (int bj = 0; bj < 2; ++bj) { const int c = col0 + bj * 128;
                const f32x4 b0 = *(const f32x4*)(b1 + c), bb1 = *(const f32x4*)(b1 + c + 4);
#pragma unroll
                for (int ai = 0; ai < 2; ++ai)
#pragma unroll
                    for (int m = 0; m < 4; ++m) { f32x4 v0 = acc[ai][bj][m][0] + b0, v1 = acc[ai][bj][m][1] + bb1;
#pragma unroll
                        for (int i = 0; i < 4; ++i) { const float a = fmaxf(v0[i], 0.f), b = fmaxf(v1[i], 0.f); v0[i] = a * a; v1[i] = b * b; }
                        u32x4 w; w.x = pg8::cvt_pk_bf16(v0[0], v0[1]); w.y = pg8::cvt_pk_bf16(v0[2], v0[3]); w.z = pg8::cvt_pk_bf16(v1[0], v1[1]); w.w = pg8::cvt_pk_bf16(v1[2], v1[3]);
                        st16_wt(H + (size_t)(row0 + ai * 128 + m * 16) * FF + c, w); } }
        } else {
            const bool lat = u.pm < 64; const int bsel = lat ? (u.pm >> 3) : 8;
            const float* gate = (const float*)(p.ws + WS_MOD) + (size_t)(l * 9 + bsel) * 6144 + (kind == 1 ? 2 : 5) * 1024;
            const float* bias = p.in[I_B2] + l * D;
            const float bsc = kind == 3 ? 1.f : 0.f;
            const int rloc = (lat ? u.pm : u.pm - 64) * 256 + wr * 64 + fr;
            bf16_t* rs = lat ? (bf16_t*)p.out : (bf16_t*)(p.ws + WS_CTXRES);
            const bool f32src = (kind == 1 && l == 0);
            const float* ipf = (lat ? p.in[I_X] : p.in[I_CTX]) + (size_t)rloc * D;
            const bf16_t* ipb = rs + (size_t)rloc * D;
            bf16_t* op = ((kind == 3 && l == 1) ? (bf16_t*)(p.ws + WS_XN) : rs) + (size_t)rloc * D;
            const int col0 = u.pn * 256 + wc * 32 + 8 * fq;
#pragma unroll
            for (int bj = 0; bj < 2; ++bj) { const int c = col0 + bj * 128;
                const f32x4 g0 = *(const f32x4*)(gate + c), g1 = *(const f32x4*)(gate + c + 4);
                const f32x4 b0 = *(const f32x4*)(bias + c) * bsc, b1 = *(const f32x4*)(bias + c + 4) * bsc;
#pragma unroll
                for (int ai = 0; ai < 2; ++ai)
#pragma unroll
                    for (int m = 0; m < 4; ++m) { const size_t ro = (size_t)(ai * 128 + m * 16) * D + c;
                        f32x4 x0, x1;
                        if (f32src) { x0 = *(const f32x4*)(ipf + ro); x1 = *(const f32x4*)(ipf + ro + 4); }
                        else { const u32x4 xb = *(const u32x4*)(ipb + ro); x0 = (f32x4){bf_lo(xb.x), bf_hi(xb.x), bf_lo(xb.y), bf_hi(xb.y)}; x1 = (f32x4){bf_lo(xb.z), bf_hi(xb.z), bf_lo(xb.w), bf_hi(xb.w)}; }
                        const f32x4 y0 = x0 + g0 * (acc[ai][bj][m][0] + b0), y1 = x1 + g1 * (acc[ai][bj][m][1] + b1);
                        u32x4 w; w.x = pk2(y0[0], y0[1]); w.y = pk2(y0[2], y0[3]); w.z = pk2(y1[0], y1[1]); w.w = pk2(y1[2], y1[3]);
                        st16_wt(op + ro, w); } }
        }
    }
};

struct Order {
    pg8::StaticOrder so; int nslice;
    __device__ __forceinline__ bool next(int i, pg8::Unit& u) const {
        if (nslice == 0) return so.next(i, u);
        const int Lx = i * so.G + so.c; if (Lx >= nslice * 32) return false;
        u.ks = Lx >> 5; const int t = Lx & 31; u.pm = t >> 2; u.pn = t & 3; return true;
    }
    __device__ __forceinline__ void a_ready(const pg8::Unit&) const {}
    __device__ __forceinline__ void done(const pg8::Unit&) const {}
};
__device__ __forceinline__ int inproj_dest(int n) {
    if (n < 512) return n;
    if (n < 1024) return 1536 + (n - 512);
    if (n < 1040) return 2816 + (n - 1024);
    if (n < 1552) return 2048 + (n - 1040);
    if (n < 2064) return 512 + (n - 1552);
    if (n < 2320) return 1024 + (n - 2064);
    if (n < 2336) return 2832 + (n - 2320);
    if (n < 2592) return 1280 + (n - 2336);
    return 2560 + (n - 2592);
}
template <bool INMAP>
__device__ __forceinline__ void transpose_item(const float* W, int K, int N, bf16_t* WT, LAS float* scr, int item, int lane) {
    const int nblk = N / 32, kb = item / nblk, nb = item % nblk, k0 = 64 * kb, n0 = 32 * nb;
#pragma unroll 8
    for (int i = 0; i < 32; ++i) { const int kk = 2 * i + (lane >> 5); scr[kk * 33 + (lane & 31)] = W[(size_t)(k0 + kk) * N + n0 + (lane & 31)]; }
    asm volatile("s_waitcnt lgkmcnt(0)" ::: "memory");
    const int c = lane & 7;
#pragma unroll
    for (int j = 0; j < 4; ++j) { const int n = (lane >> 3) + 8 * j; const LAS float* s = scr + (8 * c) * 33 + n;
        u32x4 o; o.x = pk2(s[0 * 33], s[1 * 33]); o.y = pk2(s[2 * 33], s[3 * 33]); o.z = pk2(s[4 * 33], s[5 * 33]); o.w = pk2(s[6 * 33], s[7 * 33]);
        const int row = INMAP ? inproj_dest(n0 + n) : (n0 + n);
        st16_wt(WT + (size_t)row * K + k0 + 8 * c, o); }
    asm volatile("s_waitcnt lgkmcnt(0)" ::: "memory");
}
__device__ __forceinline__ void phase0(const Params& p, LAS unsigned char* L) {
    const int tid = tid_opaque(), lane = tid & 63, wave = tid >> 6;
    LAS float* sS = (LAS float*)L;
    LAS float* red = (LAS float*)(L + 36864);
    for (int i = tid; i < 9 * 1024; i += NTHREADS) { const int v = i >> 10, k = i & 1023; const float x = v < 8 ? p.in[I_C][v * 1024 + k] : p.in[I_CCTX][k]; sS[i] = siluf_(x); }
    __syncthreads();
    float* mod = (float*)(p.ws + WS_MOD);
    for (int unit = blockIdx.x; unit < 192; unit += gridDim.x) {
        const int l = unit / 96, nb = (unit % 96) * 64;
        const float* W = p.in[I_WADA] + (size_t)l * 1024 * 6144 + nb + lane;
        float acc[9];
#pragma unroll
        for (int v = 0; v < 9; ++v) acc[v] = 0.f;
#pragma unroll 8
        for (int k = wave * 128; k < wave * 128 + 128; k += 4) {
            const float w0 = W[(size_t)k * 6144], w1 = W[(size_t)(k + 1) * 6144], w2 = W[(size_t)(k + 2) * 6144], w3 = W[(size_t)(k + 3) * 6144];
#pragma unroll
            for (int v = 0; v < 9; ++v) { const f32x4 s4 = *(const LAS f32x4*)(sS + v * 1024 + k); acc[v] += (s4.x * w0 + s4.y * w1) + (s4.z * w2 + s4.w * w3); } }
#pragma unroll
        for (int v = 0; v < 9; ++v) red[(wave * 9 + v) * 64 + lane] = acc[v];
        __syncthreads();
        for (int i = tid; i < 576; i += NTHREADS) { const int v = i >> 6, ln = i & 63; float s = 0.f;
#pragma unroll
            for (int w = 0; w < 8; ++w) s += red[(w * 9 + v) * 64 + ln];
            st4_wt(mod + (size_t)(l * 9 + v) * 6144 + nb + ln, s + p.in[I_BADA][l * 6144 + nb + ln]); }
        __syncthreads();
    }
    __syncthreads();
    LAS float* scr = (LAS float*)(L + wave * 16384);
    const int gw = blockIdx.x * NWAVES + wave, NGW = gridDim.x * NWAVES;
    constexpr int I_IN = 16 * 89, I_OUT = 16 * 32, I_M1 = 16 * 128, I_M2 = 64 * 32, I_LAYER = I_IN + I_OUT + I_M1 + I_M2;
    const bool bal = (gridDim.x == 256); const int bx = blockIdx.x;
    const int nmine = !bal ? (2 * I_LAYER + NGW - 1) / NGW : (bx >= 192 ? 11 : (bx < 36 ? 5 : 4));
    for (int j = 0; j < nmine; ++j) {
        int it;
        if (!bal) it = gw + j * NGW;
        else if (bx >= 192) it = (bx - 192) * 88 + wave * 11 + j;
        else it = j < 4 ? 5632 + bx * 32 + wave * 4 + j : 11776 + bx * 8 + wave;
        if (it >= 2 * I_LAYER) continue;
        const int l = it / I_LAYER; int r = it % I_LAYER;
        bf16_t* wt = (bf16_t*)(p.ws + WS_WT + (size_t)l * WT_LAYER);
        if (r < I_IN) { transpose_item<true>(p.in[I_WIN] + (size_t)l * 1024 * PIN, 1024, PIN, wt, scr, r, lane); continue; } r -= I_IN;
        if (r < I_OUT) { transpose_item<false>(p.in[I_WOUT] + (size_t)l * 1024 * 1024, 1024, 1024, (bf16_t*)((unsigned char*)wt + WT_OUT), scr, r, lane); continue; } r -= I_OUT;
        if (r < I_M1) { transpose_item<false>(p.in[I_W1] + (size_t)l * 1024 * FF, 1024, FF, (bf16_t*)((unsigned char*)wt + WT_W1), scr, r, lane); continue; } r -= I_M1;
        transpose_item<false>(p.in[I_W2] + (size_t)l * FF * 1024, FF, 1024, (bf16_t*)((unsigned char*)wt + WT_W2), scr, r, lane);
    }
}

__device__ __forceinline__ void normmod_phase(const Params& p, int l, int which) {
    const bool first = (which == 0 && l == 0);
    const float* xlat = p.in[I_X]; const float* xctx = p.in[I_CTX];
    const bf16_t* rlat = (const bf16_t*)p.out; const bf16_t* rctx = (const bf16_t*)(p.ws + WS_CTXRES);
    const int nrows = (l == 1 && which == 1) ? RL : RT;
    const float* g = (which == 0 ? p.in[I_GMIX] : p.in[I_GMLP]) + l * D; const float* modl = (const float*)(p.ws + WS_MOD) + (size_t)l * 9 * 6144;
    const int shi = which == 0 ? 0 : 3, sci = shi + 1;
    const int tid = tid_opaque(), lane = tid & 63, wave = tid >> 6;
    const int gw = blockIdx.x * NWAVES + wave, NGW = gridDim.x * NWAVES;
    bf16_t* XN = (bf16_t*)(p.ws + WS_XN);
    for (int row = gw; row < nrows; row += NGW) {
        const bool lat = row < RL; const int bsel = lat ? (row >> 11) : 8;
        const float* xr = lat ? xlat + (size_t)row * D : xctx + (size_t)(row - RL) * D;
        const bf16_t* xb = lat ? rlat + (size_t)row * D : rctx + (size_t)(row - RL) * D;
        const float* sh = modl + bsel * 6144 + shi * 1024; const float* sc = modl + bsel * 6144 + sci * 1024;
        f32x4 v[4]; float s = 0.f;
        const bool fold = (which == 0 && l == 1 && !lat);
#pragma unroll
        for (int j = 0; j < 4; ++j) { const int cj = 8 * lane + 512 * (j >> 1) + 4 * (j & 1);
            if (first) v[j] = *(const f32x4*)(xr + cj); else { const u32x2 t = *(const u32x2*)(xb + cj); v[j] = (f32x4){bf_lo(t.x), bf_hi(t.x), bf_lo(t.y), bf_hi(t.y)}; }
            if (fold) { const bf16_t* pt = (const bf16_t*)(p.ws + WS_PART) + (size_t)(row - RL) * D + cj;
                f32x4 a = *(const f32x4*)(p.in[I_B2] + cj);
#pragma unroll
                for (int ks = 0; ks < 8; ++ks) { const u32x2 t = *(const u32x2*)(pt + (size_t)ks * RC * D); a = a + (f32x4){bf_lo(t.x), bf_hi(t.x), bf_lo(t.y), bf_hi(t.y)}; }
                v[j] = v[j] + *(const f32x4*)((const float*)(p.ws + WS_MOD) + 8 * 6144 + 5 * 1024 + cj) * a; } s += (v[j].x * v[j].x + v[j].y * v[j].y) + (v[j].z * v[j].z + v[j].w * v[j].w); }
        const float rs = rsqrtf(wave_sum(s) * (1.f / D) + EPS);
#pragma unroll
        for (int h = 0; h < 2; ++h) { const int c = 8 * lane + 512 * h;
            const f32x4 g0 = *(const f32x4*)(g + c), g1 = *(const f32x4*)(g + c + 4), s0 = *(const f32x4*)(sh + c), s1 = *(const f32x4*)(sh + c + 4), c0 = *(const f32x4*)(sc + c), c1 = *(const f32x4*)(sc + c + 4);
            const f32x4 o0 = v[2 * h] * rs * g0 * (c0 + 1.f) + s0, o1 = v[2 * h + 1] * rs * g1 * (c1 + 1.f) + s1;
            u32x4 w; w.x = pk2(o0.x, o0.y); w.y = pk2(o0.z, o0.w); w.z = pk2(o1.x, o1.y); w.w = pk2(o1.z, o1.w);
            st16_wt(XN + (size_t)row * D + c, w); }
    }
}
__device__ __forceinline__ void final_phase(const Params& p) {
    const int tid = tid_opaque(), lane = tid & 63, wave = tid >> 6;
    const int gw = blockIdx.x * NWAVES + wave, NGW = gridDim.x * NWAVES;
    const float* g = p.in[I_GFIN]; const bf16_t* X = (const bf16_t*)(p.ws + WS_XN);
    for (int row = gw; row < RL; row += NGW) {
        const bf16_t* xb = X + (size_t)row * D; float* xr = p.out + (size_t)row * D;
        f32x4 v[4]; float s = 0.f;
#pragma unroll
        for (int j = 0; j < 4; ++j) { const u32x2 t = *(const u32x2*)(xb + 4 * lane + 256 * j); v[j] = (f32x4){bf_lo(t.x), bf_hi(t.x), bf_lo(t.y), bf_hi(t.y)}; s += (v[j].x * v[j].x + v[j].y * v[j].y) + (v[j].z * v[j].z + v[j].w * v[j].w); }
        const float rs = rsqrtf(wave_sum(s) * (1.f / D) + EPS);
#pragma unroll
        for (int j = 0; j < 4; ++j) { const int c = 4 * lane + 256 * j; const f32x4 gg = *(const f32x4*)(g + c); *(f32x4*)(xr + c) = v[j] * rs * gg; }
    }
}
__device__ __forceinline__ void finalize_phase(const Params& p, int l, int nrows) {
    const int tid = tid_opaque(), lane = tid & 63, wave = tid >> 6;
    const int gw = blockIdx.x * NWAVES + wave, NGW = gridDim.x * NWAVES;
    bf16_t* RF = (bf16_t*)(p.ws + WS_XN); const bf16_t* RB = (const bf16_t*)(p.ws + WS_RAWB); const bf16_t* P = (const bf16_t*)(p.ws + WS_PR);
    const float* gha = p.in[I_GHA] + l * 256; const float* gnb = p.in[I_GNB] + l * 512;
    for (int row = gw; row < nrows; row += NGW) {
        bf16_t* rf = RF + (size_t)row * D + 4 * lane; const bf16_t* rb = RB + (size_t)row * D + 4 * lane; const bf16_t* pr = P + (size_t)row * PRLD + 4 * lane;
        float v[4][4];
#pragma unroll
        for (int sgi = 0; sgi < 4; ++sgi) { const u32x2 a = *(const u32x2*)(rf + sgi * 256), b = *(const u32x2*)(rb + sgi * 256);
            v[sgi][0] = bf_lo(a.x) + bf_lo(b.x); v[sgi][1] = bf_hi(a.x) + bf_hi(b.x); v[sgi][2] = bf_lo(a.y) + bf_lo(b.y); v[sgi][3] = bf_hi(a.y) + bf_hi(b.y); }
        const u32x2 ov = *(const u32x2*)(pr + 256), z0 = *(const u32x2*)(pr + 512), z1 = *(const u32x2*)(pr + 768), gv = *(const u32x2*)(pr + 1024);
        { float s = v[0][0] * v[0][0] + v[0][1] * v[0][1] + v[0][2] * v[0][2] + v[0][3] * v[0][3];
#pragma unroll
          for (int o = 1; o < 16; o <<= 1) s += __shfl_xor(s, o);
          const float rs = rsqrtf(s * (1.f / 64.f) + EPS); const f32x4 gg = *(const f32x4*)(gha + 4 * lane);
          v[0][0] = v[0][0] * rs * gg.x * sigmoidf_(bf_lo(ov.x)); v[0][1] = v[0][1] * rs * gg.y * sigmoidf_(bf_hi(ov.x));
          v[0][2] = v[0][2] * rs * gg.z * sigmoidf_(bf_lo(ov.y)); v[0][3] = v[0][3] * rs * gg.w * sigmoidf_(bf_hi(ov.y)); }
        { v[1][0] *= siluf_(bf_lo(z0.x)); v[1][1] *= siluf_(bf_hi(z0.x)); v[1][2] *= siluf_(bf_lo(z0.y)); v[1][3] *= siluf_(bf_hi(z0.y));
          v[2][0] *= siluf_(bf_lo(z1.x)); v[2][1] *= siluf_(bf_hi(z1.x)); v[2][2] *= siluf_(bf_lo(z1.y)); v[2][3] *= siluf_(bf_hi(z1.y));
          float s = 0.f;
#pragma unroll
          for (int i = 0; i < 4; ++i) s += v[1][i] * v[1][i] + v[2][i] * v[2][i];
          const float rs = rsqrtf(wave_sum(s) * (1.f / 512.f) + EPS);
          const f32x4 g0 = *(const f32x4*)(gnb + 4 * lane), g1 = *(const f32x4*)(gnb + 256 + 4 * lane);
#pragma unroll
          for (int i = 0; i < 4; ++i) { v[1][i] = v[1][i] * rs * g0[i]; v[2][i] = v[2][i] * rs * g1[i]; } }
        { v[3][0] *= gelu_tanh(bf_lo(gv.x)); v[3][1] *= gelu_tanh(bf_hi(gv.x)); v[3][2] *= gelu_tanh(bf_lo(gv.y)); v[3][3] *= gelu_tanh(bf_hi(gv.y)); }
#pragma unroll
        for (int sgi = 0; sgi < 4; ++sgi) { u32x2 w; w.x = pk2(v[sgi][0], v[sgi][1]); w.y = pk2(v[sgi][2], v[sgi][3]); st8_wt(rf + sgi * 256, w); }
    }
}

__device__ __forceinline__ void conv_phase(const Params& p, LAS unsigned char* L, int l) {
    const int tid = tid_opaque();
    if (tid >= 384) return;
    const int stream = tid >= 192 ? 1 : 0, cgp = tid - 192 * stream, c0 = cgp * 8;
    float w[5][8];
#pragma unroll
    for (int j = 0; j < 5; ++j)
#pragma unroll
        for (int i = 0; i < 8; ++i) { const int c = c0 + i; float v;
            if (c0 < 512) v = j < 4 ? p.in[I_CAW][(l * 4 + j) * 512 + c] : p.in[I_CAB][l * 512 + c];
            else if (c0 < 1280) v = j < 4 ? p.in[I_CBW][(l * 4 + j) * 768 + (c - 512)] : p.in[I_CBB][l * 768 + (c - 512)];
            else v = j < 4 ? p.in[I_CCW][(l * 4 + j) * 256 + (c - 1280)] : p.in[I_CCB][l * 256 + (c - 1280)];
            w[j][i] = v; }
    const bf16_t* PA = (const bf16_t*)(p.ws + WS_PA); bf16_t* CV = (bf16_t*)(p.ws + WS_CV);
    const bool act = c0 < 1280; const float qs = c0 < 256 ? 0.125f : 1.f;
    for (int it = blockIdx.x; it < 2304; it += gridDim.x) {
        const int seg = 2 * it + stream;
        const bool lat = seg < 4096; const int sb = lat ? seg : seg - 4096;
        const int bb = lat ? (sb >> 9) : (sb >> 6), pf0 = (lat ? (sb & 511) : (sb & 63)) * 4;
        const int Lseg = lat ? SEQL : CTXL, base = lat ? bb * SEQL : RL + bb * CTXL;
        const bool cm = lat && !act;
        u32x4 x[7];
#pragma unroll
        for (int r = 0; r < 7; ++r) { const int pj = pf0 + r - 2; const bool ok = (pj >= 0) && (pj < Lseg); const int pq = ok ? pj : pf0;
            const int tj = cm ? ((pq & 31) * 64 + (pq >> 5)) : pq;
            x[r] = *(const u32x4*)(PA + (size_t)(base + tj) * PALD + c0); if (!ok) x[r] = (u32x4){0u, 0u, 0u, 0u}; }
#pragma unroll
        for (int o = 0; o < 4; ++o) {
            float v[8];
#pragma unroll
            for (int i = 0; i < 8; ++i) v[i] = w[4][i];
#pragma unroll
            for (int j = 0; j < 4; ++j) { const u32x4 x_ = x[o + j];
                v[0] += w[j][0] * bf_lo(x_.x); v[1] += w[j][1] * bf_hi(x_.x); v[2] += w[j][2] * bf_lo(x_.y); v[3] += w[j][3] * bf_hi(x_.y);
                v[4] += w[j][4] * bf_lo(x_.z); v[5] += w[j][5] * bf_hi(x_.z); v[6] += w[j][6] * bf_lo(x_.w); v[7] += w[j][7] * bf_hi(x_.w); }
            if (act) {
#pragma unroll
                for (int i = 0; i < 8; ++i) v[i] = siluf_(v[i]) * qs;
            }
            const int pq = pf0 + o; const int tj = cm ? ((pq & 31) * 64 + (pq >> 5)) : pq;
            u32x4 wv; wv.x = pk2(v[0], v[1]); wv.y = pk2(v[2], v[3]); wv.z = pk2(v[4], v[5]); wv.w = pk2(v[6], v[7]);
            st16_wt(CV + (size_t)(base + tj) * PALD + c0, wv);
        }
    }
}

template <int MODE>
__device__ __forceinline__ void seq_unit(const Params& p, LAS unsigned char* L, int l, int b, int hd, int d) {
    const int tid = tid_opaque(), lane = tid & 63, wave = __builtin_amdgcn_readfirstlane(tid >> 6);
    const int r16 = lane & 15, q4 = lane >> 4;
    const int wpar = wave & 1, w8 = (wave >> 1) * 16;
    constexpr int OB = 40960, LSV = 88;
    LAS bf16_t* sS = (LAS bf16_t*)(L + 81920); LAS bf16_t* sC = (LAS bf16_t*)(L + 91136);
    LAS float* tabG = (LAS float*)(L + 114176); LAS float* tabM = (LAS float*)(L + 123392); LAS float* tabB = (LAS float*)(L + 132608);
    LAS bf16_t* sO = (LAS bf16_t*)(L + 142336);
    LAS float* rden = (LAS float*)(L + 141824);
    const bf16_t* CV = (const bf16_t*)(p.ws + WS_CV);
    const float* G = (const float*)(p.ws + WS_GATES);
    bf16_t* outp = (bf16_t*)(p.ws + (d ? WS_RAWB : WS_XN));
    const bf16_t* P2; int ld2;
    int col0, col1, col2, ocol, gc0, gc1 = 0; float gb0, gb1 = 0.f, Aneg = 0.f, dskip = 0.f;
    if (MODE == 0) { col0 = hd * 64; col1 = 256 + hd * 64; col2 = hd * 64; P2 = (const bf16_t*)(p.ws + WS_PR); ld2 = PRLD; ocol = hd * 64; gc0 = d * 4 + hd; gc1 = 8 + d * 4 + hd;
        gb0 = p.in[I_BIG][(l * 2 + d) * 4 + hd]; gb1 = p.in[I_BFG][(l * 2 + d) * 4 + hd]; }
    else { const int g = hd >> 2; col0 = 1152 + g * 64; col1 = 1024 + g * 64; col2 = 512 + hd * 64; P2 = CV; ld2 = PALD; ocol = 256 + hd * 64; gc0 = 16 + d * 8 + hd;
        gb0 = p.in[I_DTB][(l * 2 + d) * 8 + hd]; Aneg = -__expf(p.in[I_ALOG][(l * 2 + d) * 8 + hd]); dskip = p.in[I_DSKIP][l * 8 + hd]; }
    __syncthreads();
    for (int i = tid; i < 80 * LS / 2; i += NTHREADS) ((LAS unsigned*)sC)[i] = 0u;
    if (MODE == 0 && tid < 128) { LAS unsigned char* ob = L + (tid >> 6) * OB; const int row = tid & 63;
        unsigned z_ = 0u, o_ = 0x00003F80u; asm volatile("" : "+v"(z_), "+v"(o_));
        const u32x4 zz_ = {z_, z_, z_, z_}, oo_ = {o_, z_, z_, z_};
        *(LAS u32x4*)(ob + 18432 + (row * LSV + 64) * 2) = oo_; *(LAS u32x4*)(ob + 18432 + (row * LSV + 72) * 2) = zz_;
        *(LAS u32x4*)(ob + 29696 + (row * LSV + 64) * 2) = zz_; *(LAS u32x4*)(ob + 29696 + (row * LSV + 72) * 2) = zz_; }
    for (int c = wave; c < 36; c += 8) {
        const bool isctx = c < 4; const int cc = isctx ? c : c - 4; const int Lseg = isctx ? CTXL : SEQL; const int base = isctx ? RL + b * CTXL : b * SEQL;
        const int pos0 = cc * 64 + lane; const int tau0 = d ? Lseg - 1 - pos0 : pos0; const float* gp = G + (size_t)(base + tau0) * 32;
        if (MODE == 0) {
            const float ig = gp[gc0] + gb0, fg = gp[gc1] + gb1;
            const float lf = fminf(fg, 0.f) - log1pf(__expf(-fabsf(fg)));
            float bs = lf;
#pragma unroll
            for (int o = 1; o < 64; o <<= 1) { const float t = __shfl_up(bs, o); if (lane >= o) bs += t; }
            const float g = ig - bs; float M = g;
#pragma unroll
            for (int o = 1; o < 64; o <<= 1) { const float t = __shfl_up(M, o); if (lane >= o) M = fmaxf(M, t); }
            tabG[c * 64 + lane] = g; tabM[c * 64 + lane] = M; tabB[c * 64 + lane] = bs;
        } else {
            const float dtv = softplusf_(gp[gc0] + gb0);
            float cs = dtv * Aneg;
#pragma unroll
            for (int o = 1; o < 64; o <<= 1) { const float t = __shfl_up(cs, o); if (lane >= o) cs += t; }
            tabG[c * 64 + lane] = cs; tabM[c * 64 + lane] = dtv;
        }
    }
    f32x4 st[2] = {{0.f, 0.f, 0.f, 0.f}, {0.f, 0.f, 0.f, 0.f}};
    f32x4 stx = {0.f, 0.f, 0.f, 0.f};
    f32x4 res[2] = {{0.f, 0.f, 0.f, 0.f}, {0.f, 0.f, 0.f, 0.f}};
    float m_in = 0.f;
    u32x4 r0, r1, r2, r3, r4, r5;
#define PREFETCH(CN) do { const int cn_ = (CN); const bool isctx_ = cn_ < 4; const int cc_ = isctx_ ? cn_ : cn_ - 4; const int Lseg_ = isctx_ ? CTXL : SEQL; const int base_ = isctx_ ? RL + b * CTXL : b * SEQL; \
        const int pos_ = cc_ * 64 + lane; const int row_ = base_ + (d ? Lseg_ - 1 - pos_ : pos_); \
        r0 = *(const u32x4*)(CV + (size_t)row_ * PALD + col0 + w8); r1 = *(const u32x4*)(CV + (size_t)row_ * PALD + col1 + w8); r2 = *(const u32x4*)(P2 + (size_t)row_ * ld2 + col2 + w8); \
        r3 = *(const u32x4*)(CV + (size_t)row_ * PALD + col0 + w8 + 8); r4 = *(const u32x4*)(CV + (size_t)row_ * PALD + col1 + w8 + 8); r5 = *(const u32x4*)(P2 + (size_t)row_ * ld2 + col2 + w8 + 8); } while (0)
#define WRITEOUT(CP) do { const int cp_ = (CP); const bool isctx_ = cp_ < 4; const int cc_ = isctx_ ? cp_ : cp_ - 4; const int Lseg_ = isctx_ ? CTXL : SEQL; const int base_ = isctx_ ? RL + b * CTXL : b * SEQL; \
        const int tok_ = tid >> 3, grp_ = (tid & 7) * 8; const int pos_ = cc_ * 64 + tok_; const int row_ = base_ + (d ? Lseg_ - 1 - pos_ : pos_); \
        st16_wt(outp + (size_t)row_ * D + ocol + grp_, *(const LAS u32x4*)(sO + tok_ * LS + grp_)); } while (0)
    r0 = r1 = r2 = r3 = r4 = r5 = (u32x4){0u, 0u, 0u, 0u};
    if (wpar == 0) PREFETCH(0); else PREFETCH(1);
    __syncthreads();
    for (int c = -1; c < 36; ++c) {
        const int cur = c & 1;
        LAS unsigned char* Oc = L + cur * OB; LAS unsigned char* On = L + (cur ^ 1) * OB;
        LAS bf16_t* sQ = (LAS bf16_t*)Oc; LAS bf16_t* sK = (LAS bf16_t*)(Oc + 9216); LAS bf16_t* sV = (LAS bf16_t*)(Oc + 18432); LAS bf16_t* sWV = (LAS bf16_t*)(Oc + 29696);
        const LAS float* tg = tabG + (c < 0 ? 0 : c) * 64; const LAS float* tm = tabM + (c < 0 ? 0 : c) * 64; const LAS float* tb = tabB + (c < 0 ? 0 : c) * 64;
        float m_out = 0.f, decay = 1.f;
        if (c >= 0) {
            if (MODE == 0) { const float mm_end = fmaxf(m_in, tm[63]); decay = __expf(m_in - mm_end); m_out = tb[63] + mm_end; }
            else decay = __expf(tg[63]);
#pragma unroll
            for (int i = 0; i < 2; ++i) { const int idx = wave + 8 * i, stile = idx >> 2, ttile = idx & 3;
                f32x4 acc = {0.f, 0.f, 0.f, 0.f}; acc = mma64(sK + stile * 16 * LS, sQ + ttile * 16 * LS, lane, acc);
                const int t = ttile * 16 + r16, s0 = stile * 16 + 4 * q4;
                const float bt = (MODE == 0) ? -fmaxf(m_in, tm[t]) : tg[t];
                float o[4];
#pragma unroll
                for (int j = 0; j < 4; ++j) { const int s = s0 + j;
                    const float e = (MODE == 0) ? __expf(tg[s] + bt) : __expf(bt - tg[s]) * tm[s];
                    o[j] = (s <= t) ? acc[j] * e : 0.f; }
                u32x2 w; w.x = pk2(o[0], o[1]); w.y = pk2(o[2], o[3]); *(LAS u32x2*)(sS + t * LS + s0) = w; }
        }
        LDS_BARRIER();
        if (c >= 1) WRITEOUT(c - 1);
        if (c >= 0) {
            LAS bf16_t* sCc = sC + cur * 80 * LS; LAS bf16_t* sCn = sC + (cur ^ 1) * 80 * LS;
#pragma unroll
            for (int i = 0; i < 2; ++i) { const int idx = wave + 8 * i, vtile = idx >> 2, ttile = idx & 3; const int t = ttile * 16 + r16;
                f32x4 a = {0.f, 0.f, 0.f, 0.f}; a = mma64(sCc + vtile * 16 * LS, sQ + ttile * 16 * LS, lane, a);
                const float dl = (MODE == 0) ? __expf(m_in - fmaxf(m_in, tm[t])) : __expf(tg[t]);
                a = a * dl;
#pragma unroll
                for (int kk = 0; kk < 2; ++kk) { const bf16x8 fa = tr_frag(sV, LSV, vtile, kk, lane); const bf16x8 fb = *(const LAS bf16x8*)(sS + (ttile * 16 + r16) * LS + kk * 32 + q4 * 8);
                    a = __builtin_amdgcn_mfma_f32_16x16x32_bf16(fa, fb, a, 0, 0, 0); }
                res[i] = a; }
            if (MODE == 0 && wave < 4) { const int t = wave * 16 + r16;
                f32x4 a = {0.f, 0.f, 0.f, 0.f}; a = mma64(sCc + 64 * LS, sQ + wave * 16 * LS, lane, a);
                a = a * __expf(m_in - fmaxf(m_in, tm[t]));
#pragma unroll
                for (int kk = 0; kk < 2; ++kk) { const bf16x8 fa = tr_frag(sV, LSV, 4, kk, lane); const bf16x8 fb = *(const LAS bf16x8*)(sS + (wave * 16 + r16) * LS + kk * 32 + q4 * 8);
                    a = __builtin_amdgcn_mfma_f32_16x16x32_bf16(fa, fb, a, 0, 0, 0); }
                if (q4 == 0) rden[t] = a[0]; }
#pragma unroll
            for (int i = 0; i < 2; ++i) { const int idx = wave + 8 * i, ktile = idx >> 2, vtile = idx & 3;
                f32x4 a = st[i] * decay;
#pragma unroll
                for (int kk = 0; kk < 2; ++kk) { const bf16x8 fa = tr_frag(sK, LS, ktile, kk, lane); const bf16x8 fb = tr_frag(sWV, LSV, vtile, kk, lane);
                    a = __builtin_amdgcn_mfma_f32_16x16x32_bf16(fa, fb, a, 0, 0, 0); }
                st[i] = a;
                u32x2 w; w.x = pk2(a[0], a[1]); w.y = pk2(a[2], a[3]); *(LAS u32x2*)(sCn + (vtile * 16 + r16) * LS + ktile * 16 + 4 * q4) = w; }
            if (MODE == 0 && wave >= 4) { const int ktile = wave - 4;
                f32x4 a = stx * decay;
#pragma unroll
                for (int kk = 0; kk < 2; ++kk) { const bf16x8 fa = tr_frag(sK, LS, ktile, kk, lane); const bf16x8 fb = tr_frag(sWV, LSV, 4, kk, lane);
                    a = __builtin_amdgcn_mfma_f32_16x16x32_bf16(fa, fb, a, 0, 0, 0); }
                stx = a;
                u32x2 w; w.x = pk2(a[0], a[1]); w.y = pk2(a[2], a[3]); *(LAS u32x2*)(sCn + (64 + r16) * LS + ktile * 16 + 4 * q4) = w; }
        }
        if (c + 1 < 36 && ((c + 1) & 1) == wpar) {
            const int cn = c + 1;
            LAS bf16_t* nQ = (LAS bf16_t*)On; LAS bf16_t* nK = (LAS bf16_t*)(On + 9216); LAS bf16_t* nV = (LAS bf16_t*)(On + 18432); LAS bf16_t* nWV = (LAS bf16_t*)(On + 29696);
            float om;
            if (MODE == 0) om = __expf(tabG[cn * 64 + lane] - fmaxf(m_out, tabM[cn * 64 + 63]));
            else om = __expf(tabG[cn * 64 + 63] - tabG[cn * 64 + lane]) * tabM[cn * 64 + lane];
            if (MODE == 0 && (wave >> 1) == 0) nWV[lane * LSV + 64] = (bf16_t)f2bf(om);
            *(LAS u32x4*)(nQ + lane * LS + w8) = r0; *(LAS u32x4*)(nQ + lane * LS + w8 + 8) = r3;
            *(LAS u32x4*)(nK + lane * LS + w8) = r1; *(LAS u32x4*)(nK + lane * LS + w8 + 8) = r4;
            *(LAS u32x4*)(nV + lane * LSV + w8) = r2; *(LAS u32x4*)(nV + lane * LSV + w8 + 8) = r5;
            { u32x4 wv; wv.x = pk2(bf_lo(r2.x) * om, bf_hi(r2.x) * om); wv.y = pk2(bf_lo(r2.y) * om, bf_hi(r2.y) * om); wv.z = pk2(bf_lo(r2.z) * om, bf_hi(r2.z) * om); wv.w = pk2(bf_lo(r2.w) * om, bf_hi(r2.w) * om);
              *(LAS u32x4*)(nWV + lane * LSV + w8) = wv;
              wv.x = pk2(bf_lo(r5.x) * om, bf_hi(r5.x) * om); wv.y = pk2(bf_lo(r5.y) * om, bf_hi(r5.y) * om); wv.z = pk2(bf_lo(r5.z) * om, bf_hi(r5.z) * om); wv.w = pk2(bf_lo(r5.w) * om, bf_hi(r5.w) * om);
              *(LAS u32x4*)(nWV + lane * LSV + w8 + 8) = wv; }
            if (c + 3 < 36) PREFETCH(c + 3);
        }
        LDS_BARRIER();
        if (c >= 0) {
            const bool isctx = c < 4; const int cc = isctx ? c : c - 4; const int Lseg = isctx ? CTXL : SEQL; const int base = isctx ? RL + b * CTXL : b * SEQL;
#pragma unroll
            for (int i = 0; i < 2; ++i) { const int idx = wave + 8 * i, vtile = idx >> 2, ttile = idx & 3; const int t = ttile * 16 + r16, v0 = vtile * 16 + 4 * q4;
                f32x4 a = res[i];
                if (MODE == 0) { const float mmt = fmaxf(m_in, tm[t]); const float dn = rden[t]; a = a * __builtin_amdgcn_rcpf(fmaxf(fabsf(dn), __expf(-(tb[t] + mmt)))); }
                else if (d == 0) {
#pragma unroll
                    for (int j = 0; j < 1; ++j) { const u32x2 xv = *(const LAS u32x2*)(sV + t * LSV + v0); a[0] += dskip * bf_lo(xv.x); a[1] += dskip * bf_hi(xv.x); a[2] += dskip * bf_lo(xv.y); a[3] += dskip * bf_hi(xv.y); } }
                u32x2 w; w.x = pk2(a[0], a[1]); w.y = pk2(a[2], a[3]);
                *(LAS u32x2*)(sO + t * LS + v0) = w; }
        }
        m_in = m_out;
    }
    LDS_BARRIER();
    WRITEOUT(35);
#undef WRITEOUT
#undef PREFETCH
}

__device__ __forceinline__ void rg_unit(const Params& p, LAS unsigned char* L, int l, int b, int n, int d) {
    const int tid = tid_opaque(), lane = tid & 63, wave = __builtin_amdgcn_readfirstlane(tid >> 6);
    const int tt = tid >> 3, cg8 = (tid & 7) * 8, r16 = lane & 15, q4 = lane >> 4;
    LAS bf16_t* sXb = (LAS bf16_t*)(L + 0); LAS bf16_t* sWt = (LAS bf16_t*)(L + 9216);
    LAS float* sXf = (LAS float*)(L + 27648); LAS float* sA = (LAS float*)(L + 44288); LAS float* sU = (LAS float*)(L + 60928); LAS float* sH = (LAS float*)(L + 77568);
    LAS float* sv = (LAS float*)(L + 95488);
    LAS float* sSeg = (LAS float*)(L + 96256);
    const bf16_t* CV = (const bf16_t*)(p.ws + WS_CV);
    bf16_t* outp = (bf16_t*)(p.ws + (d ? WS_RAWB : WS_XN));
    __syncthreads();
    for (int i = tid; i < 2 * 64 * 64; i += NTHREADS) { const int g = i >> 12, c = (i >> 6) & 63, dd = i & 63;
        const float v = p.in[I_WRG][((size_t)((((l * 2 + d) * 2 + g) * 4 + n) * 64 + c)) * 64 + dd]; sWt[(g * 64 + dd) * LS + c] = (bf16_t)f2bf(v); }
    if (tid < 64) { sv[tid] = p.in[I_BRG][((l * 2 + d) * 2 + 0) * 256 + n * 64 + tid]; sv[64 + tid] = p.in[I_BRG][((l * 2 + d) * 2 + 1) * 256 + n * 64 + tid];
        sv[128 + tid] = softplusf_(-p.in[I_LAM][(l * 2 + d) * 256 + n * 64 + tid]); }
    float hstate = 0.f;
    u32x4 rx = {0u, 0u, 0u, 0u};
    for (int c = -1; c < 36; ++c) {
        if (c >= 0) {
            float v[8] = {bf_lo(rx.x), bf_hi(rx.x), bf_lo(rx.y), bf_hi(rx.y), bf_lo(rx.z), bf_hi(rx.z), bf_lo(rx.w), bf_hi(rx.w)};
            *(LAS u32x4*)(sXb + tt * LS + cg8) = rx;
#pragma unroll
            for (int i = 0; i < 8; ++i) sXf[tt * 65 + cg8 + i] = v[i];
            LDS_BARRIER();
        }
        if (c + 1 < 36) {
            const int cn = c + 1; const bool isctx = cn < 4; const int cc = isctx ? cn : cn - 4; const int Lseg = isctx ? CTXL : SEQL;
            const int pos = cc * 64 + tt; const int pf = d ? Lseg - 1 - pos : pos;
            const int row = isctx ? RL + b * CTXL + pf : b * SEQL + (pf & 31) * 64 + (pf >> 5);
            rx = *(const u32x4*)(CV + (size_t)row * PALD + 1280 + n * 64 + cg8);
        }
        if (c >= 0) {
            { const int jt = wave & 3, dp = wave >> 2;
#pragma unroll
              for (int i = 0; i < 2; ++i) { const int dtile = 2 * dp + i;
                  f32x4 a0 = {0.f, 0.f, 0.f, 0.f}, a1 = {0.f, 0.f, 0.f, 0.f};
                  a0 = mma64(sXb + jt * 16 * LS, sWt + (dtile * 16) * LS, lane, a0);
                  a1 = mma64(sXb + jt * 16 * LS, sWt + (64 + dtile * 16) * LS, lane, a1);
                  const int dd = dtile * 16 + r16, j0 = jt * 16 + 4 * q4; const float br = sv[dd], bi = sv[64 + dd], sp = sv[128 + dd];
#pragma unroll
                  for (int jj = 0; jj < 4; ++jj) { const float rr = sigmoidf_(a0[jj] + br), ii = sigmoidf_(a1[jj] + bi); const float la = -8.f * rr * sp;
                      const float a = __expf(la); const float u = __builtin_amdgcn_sqrtf(fmaxf(1.f - a * a, 0.f)) * ii * sXf[(j0 + jj) * 65 + dd];
                      sA[(j0 + jj) * 65 + dd] = a; sU[(j0 + jj) * 65 + dd] = u; } } }
            LDS_BARRIER();
            { float pp[8], uu[8]; float P = 1.f, U = 0.f;
#pragma unroll
              for (int j = 0; j < 8; ++j) { const float a = sA[(wave * 8 + j) * 65 + lane], u = sU[(wave * 8 + j) * 65 + lane]; P = a * P; U = a * U + u; pp[j] = P; uu[j] = U; }
              sSeg[wave * 64 + lane] = P; sSeg[512 + wave * 64 + lane] = U;
              LDS_BARRIER();
              float h = hstate, hin = hstate;
#pragma unroll
              for (int s = 0; s < 8; ++s) { if (s == wave) hin = h; h = sSeg[s * 64 + lane] * h + sSeg[512 + s * 64 + lane]; }
              hstate = h;
#pragma unroll
              for (int j = 0; j < 8; ++j) sH[(wave * 8 + j) * 65 + lane] = pp[j] * hin + uu[j]; }
            LDS_BARRIER();
            { const bool isctx = c < 4; const int cc = isctx ? c : c - 4; const int Lseg = isctx ? CTXL : SEQL;
              const int pos = cc * 64 + tt; const int pf = d ? Lseg - 1 - pos : pos;
              const int row = isctx ? RL + b * CTXL + pf : b * SEQL + (pf & 31) * 64 + (pf >> 5);
              const LAS float* hp = sH + tt * 65 + cg8;
              u32x4 w; w.x = pk2(hp[0], hp[1]); w.y = pk2(hp[2], hp[3]); w.z = pk2(hp[4], hp[5]); w.w = pk2(hp[6], hp[7]);
              st16_wt(outp + (size_t)row * D + 768 + n * 64 + cg8, w); }
        }
    }
}
__device__ __forceinline__ void scan_phase(const Params& p, LAS unsigned char* L, int l) {
    for (int u = blockIdx.x; u < 256; u += gridDim.x) {
        if (u < 64) seq_unit<0>(p, L, l, u >> 3, (u & 7) >> 1, u & 1);
        else if (u < 192) { const int v = u - 64; seq_unit<1>(p, L, l, v >> 4, (v & 15) >> 1, v & 1); }
        else { const int v = u - 192; rg_unit(p, L, l, v >> 3, (v & 7) >> 1, v & 1); }
    }
}

__global__ void __launch_bounds__(NTHREADS, 2) fwd_kernel(Params p) {
    extern __shared__ __attribute__((aligned(16))) unsigned char lds_raw[];
    LAS unsigned char* L = (LAS unsigned char*)lds_raw;
    if (threadIdx.x < 4) ((LAS unsigned*)(L + LDS_BARST))[threadIdx.x] = 0u;
    __syncthreads();
    (void)xcd_barrier_post((unsigned*)(p.ws + WS_CTL), (volatile LAS unsigned*)(L + LDS_BARST));
#pragma unroll 1
    for (int ph = p.lo; ph < p.hi; ++ph) {
        Params pl = p; { unsigned char* w_ = pl.ws; asm volatile("" : "+s"(w_)); pl.ws = w_; }
        if (ph == 0) phase0(pl, L);
        else if (ph == NPHASES - 1) final_phase(pl);
        else {
            const int l = (ph - 1) / 10, k = (ph - 1) - 10 * l;
            if (k == 9 && l == 1) continue;
            if (k == 0) normmod_phase(pl, l, 0);
            else if (k == 6) normmod_phase(pl, l, 1);
            else if (k == 2) conv_phase(pl, L, l);
            else if (k == 3) scan_phase(pl, L, l);
            else if (k == 4) finalize_phase(pl, l, l == 0 ? RT : RL);
            else {
                const unsigned char* wt = pl.ws + WS_WT + (size_t)l * WT_LAYER;
                const int Mrest = l == 0 ? RT : RL;
                pg8::Gemm g; EpiAll E; E.pp = &pl; E.l = l; Order S; S.nslice = 0;
                if (k == 1)      { g.A = (const pg8::bf16_t*)(pl.ws + WS_XN); g.Bt = (const pg8::bf16_t*)wt;            g.M = RT;    g.N = PINP; g.K = D;  g.ld = D;  E.kind = 0; }
                else if (k == 5) { g.A = (const pg8::bf16_t*)(pl.ws + WS_XN); g.Bt = (const pg8::bf16_t*)(wt + WT_OUT); g.M = Mrest; g.N = D;    g.K = D;  g.ld = D;  E.kind = 1; }
                else if (k == 7) { g.A = (const pg8::bf16_t*)(pl.ws + WS_XN); g.Bt = (const pg8::bf16_t*)(wt + WT_W1);  g.M = Mrest; g.N = FF;   g.K = D;  g.ld = D;  E.kind = 2; }
                else if (k == 8) { g.A = (const pg8::bf16_t*)(pl.ws + WS_H);  g.Bt = (const pg8::bf16_t*)(wt + WT_W2);  g.M = RL;    g.N = D;    g.K = FF; g.ld = FF; E.kind = 3; }
                else             { g.A = (const pg8::bf16_t*)(pl.ws + WS_H) + (size_t)RL * FF; g.Bt = (const pg8::bf16_t*)(wt + WT_W2); g.M = RC; g.N = D; g.K = FF / 8; g.ld = FF; E.kind = 4; S.nslice = 8; }
                S.so.init(g.M, g.N, (int)gridDim.x, (int)blockIdx.x);
                pg8::gemm_phase<EpiAll, Order, true, true>(L, g, S, E);
            }
        }
        if (ph + 1 < p.hi) { XcdBarrier bar; bar.bar = (unsigned*)(pl.ws + WS_CTL); bar.x = xb_xcc_id(); bar.st = (volatile LAS unsigned*)(L + LDS_BARST); xcd_barrier(bar); }
    }
}

extern "C" void kernel_launch(void* const* d_in, const int* in_sizes, int n_in, void* d_out, int out_size, void* d_ws, size_t ws_size, hipStream_t stream) {
    static int grid = 0;
    if (grid == 0) {
        if (n_in != 31 || out_size != RL * D || ws_size < WS_END) { fprintf(stderr, "kernel_launch: unexpected problem (n_in %d out %d ws %zu)\n", n_in, out_size, ws_size); grid = -1; return; }
        int dev = 0, cus = 0, per_cu = 0;
        (void)hipGetDevice(&dev); (void)hipDeviceGetAttribute(&cus, hipDeviceAttributeMultiprocessorCount, dev);
        if (hipFuncSetAttribute((const void*)fwd_kernel, hipFuncAttributeMaxDynamicSharedMemorySize, LDS_BYTES) != hipSuccess) { fprintf(stderr, "kernel_launch: hipFuncSetAttribute failed\n"); grid = -1; return; }
        if (hipOccupancyMaxActiveBlocksPerMultiprocessor(&per_cu, (const void*)fwd_kernel, NTHREADS, LDS_BYTES) != hipSuccess || per_cu < 1) { fprintf(stderr, "kernel_launch: occupancy query says %d\n", per_cu); per_cu = 1; }
        (void)hipGetLastError();
        if (per_cu > 1) per_cu = 1;
        grid = cus * per_cu;
        if (grid > 256) grid = 256;
    }
    if (grid < 0) return;
    Params p{};
    for (int i = 0; i < 31; ++i) p.in[i] = (const float*)d_in[i];
    p.out = (float*)d_out; p.ws = (unsigned char*)d_ws;
    (void)hipMemsetAsync((unsigned char*)d_ws + WS_CTL, 0, CTL_BYTES, stream);
#if MK_N_LAUNCHES == 1
    p.lo = 0; p.hi = NPHASES;
    hipLaunchKernelGGL(fwd_kernel, dim3(grid), dim3(NTHREADS), LDS_BYTES, stream, p);
    hipError_t e = hipPeekAtLastError();
    if (e != hipSuccess) fprintf(stderr, "launch failed: %s (grid %d)\n", hipGetErrorString(e), grid);
#else
    for (int k = 0; k < NPHASES; ++k) { p.lo = k; p.hi = k + 1; hipLaunchKernelGGL(fwd_kernel, dim3(grid), dim3(NTHREADS), LDS_BYTES, stream, p); }
#endif
}
```
